# Optimizing an MI355X kernel written in HIP

```python
import math
import jax, jax.numpy as jnp
from jax import lax
import numpy as np

D_MODEL = 1024
BATCH = 4
SEQ = 8192
DEPTH = 1

MIX_WIDTH = D_MODEL
SSD_WIDTH = MIX_WIDTH // 2
SSD_HEAD_DIM = 64
SSD_HEADS = SSD_WIDTH // SSD_HEAD_DIM
SSD_GROUPS = 2
SSD_HEADS_PER_GROUP = SSD_HEADS // SSD_GROUPS
D_STATE = 128
CONV_K = 5
CHUNK = 128
ATTN_WIDTH = MIX_WIDTH - SSD_WIDTH
HEAD_DIM = 64
ATTN_HEADS = ATTN_WIDTH // HEAD_DIM
ATTN_KV_HEADS = 2
Q_PER_KV = ATTN_HEADS // ATTN_KV_HEADS
WINDOW = 128
BLOCK = 128
ROPE_DIMS = HEAD_DIM // 4
ROPE_THETA = 500000.0
D_FF = 2816
N_MOD = 9
EPS = 1e-6
DT_MIN = 0.001
DT_MAX = 0.1
A_MIN = 1.0
A_MAX = 16.0

CONV_DIM = SSD_WIDTH + 2 * SSD_GROUPS * D_STATE
N_DT = 2 * SSD_HEADS
KV_WIDTH = ATTN_KV_HEADS * HEAD_DIM
S_Z = SSD_WIDTH
S_XBC = S_Z + CONV_DIM
S_DT = S_XBC + N_DT
S_Q = S_DT + ATTN_WIDTH
S_K = S_Q + KV_WIDTH
IN_WIDTH = S_K + KV_WIDTH

kernel_name = "hybrid_ssd_swa_macaron_adaln_block"


def _rms(t):
    tf = t.astype(jnp.float32)
    return tf * lax.rsqrt(jnp.mean(tf * tf, axis=-1, keepdims=True) + EPS)


def _ada_norm(h, gain, shift, scale):
    return _rms(h) * gain * (1.0 + scale) + shift


def _swiglu(u, wg, wu, wd):
    return (jax.nn.silu(u @ wg) * (u @ wu)) @ wd


def _ssd_chunked(xs, dt, a, bm, cm, strict):
    b_, s_, g, r, p = xs.shape
    n = bm.shape[-1]
    nc = s_ // CHUNK
    da = (dt * a).reshape(b_, nc, CHUNK, g, r)
    xdt = (xs * dt[..., None]).reshape(b_, nc, CHUNK, g, r, p)
    bc = bm.reshape(b_, nc, CHUNK, g, n)
    cc = cm.reshape(b_, nc, CHUNK, g, n)
    cs = jnp.cumsum(jnp.moveaxis(da, (1, 2), (3, 4)), axis=-1)
    seg = cs[..., :, None] - cs[..., None, :]
    mask = jnp.tril(jnp.ones((CHUNK, CHUNK), dtype=bool), k=-1 if strict else 0)
    lmat = jnp.exp(jnp.where(mask, seg, -jnp.inf))
    cb = jnp.einsum('bclgn,bcsgn->bgcls', cc, bc)
    y_diag = jnp.einsum('bgcls,bgrcls,bcsgrp->bclgrp', cb, lmat, xdt)
    decay_states = jnp.exp(cs[..., -1:] - cs)
    states = jnp.einsum('bclgn,bgrcl,bclgrp->bcgrpn', bc, decay_states, xdt)
    chunk_decay = jnp.exp(cs[..., -1])

    def step(hstate, inp):
        st, dec = inp
        return hstate * dec[..., None, None] + st, hstate

    h0 = jnp.zeros((b_, g, r, p, n), jnp.float32)
    _, h_in = lax.scan(step, h0, (jnp.moveaxis(states, 1, 0), jnp.moveaxis(chunk_decay, -1, 0)))
    h_in = jnp.moveaxis(h_in, 0, 1)
    y_off = jnp.einsum('bclgn,bcgrpn,bgrcl->bclgrp', cc, h_in, jnp.exp(cs))
    return (y_diag + y_off).reshape(b_, s_, g, r, p)


def _partial_rope(t, positions):
    half = ROPE_DIMS // 2
    inv = ROPE_THETA ** (-jnp.arange(half, dtype=jnp.float32) * 2.0 / ROPE_DIMS)
    ang = positions.astype(jnp.float32)[:, :, None, None] * inv
    cos, sin = jnp.cos(ang), jnp.sin(ang)
    t1, t2, rest = t[..., :half], t[..., half:ROPE_DIMS], t[..., ROPE_DIMS:]
    return jnp.concatenate([t1 * cos - t2 * sin, t2 * cos + t1 * sin, rest], axis=-1)


def _window_attention(q, k, v, sink_logit):
    b_, s_ = q.shape[:2]
    nb = s_ // BLOCK
    qb = q.reshape(b_, nb, BLOCK, ATTN_KV_HEADS, Q_PER_KV, HEAD_DIM)

    def band(t):
        tp = jnp.pad(t, ((0, 0), (BLOCK, BLOCK), (0, 0), (0, 0)))
        tp = tp.reshape(b_, nb + 2, BLOCK, ATTN_KV_HEADS, HEAD_DIM)
        return jnp.concatenate([tp[:, :-2], tp[:, 1:-1], tp[:, 2:]], axis=2)

    kb, vb = band(k), band(v)
    scores = jnp.einsum('bnqkgd,bnjkd->bnkgqj', qb, kb) * (HEAD_DIM ** -0.5)
    qi = jnp.arange(nb)[:, None] * BLOCK + jnp.arange(BLOCK)[None, :]
    kj = jnp.arange(nb)[:, None] * BLOCK - BLOCK + jnp.arange(3 * BLOCK)[None, :]
    valid = (jnp.abs(qi[:, :, None] - kj[:, None, :]) <= WINDOW) & ((kj >= 0) & (kj < s_))[:, None, :]
    scores = jnp.where(valid[None, :, None, None], scores.astype(jnp.float32), -jnp.inf)
    sink = sink_logit.astype(jnp.float32).reshape(ATTN_KV_HEADS, Q_PER_KV)[:, :, None, None]
    m = jnp.maximum(jnp.max(scores, axis=-1, keepdims=True), sink)
    pr = jnp.exp(scores - m)
    denom = jnp.sum(pr, axis=-1, keepdims=True) + jnp.exp(sink - m)
    out = jnp.einsum('bnkgqj,bnjkd->bnqkgd', pr / denom, vb)
    return out.reshape(b_, s_, ATTN_WIDTH)


def _token_mix(u, positions, w_in, conv_w, conv_b, dt_bias, a_log, d_skip, ssd_norm_w,
               q_norm_w, k_norm_w, sink_logit, w_out):
    b_, s_, _ = u.shape
    proj = u @ w_in
    z, xbc, dt_raw, q, k, v = jnp.split(proj, [S_Z, S_XBC, S_DT, S_Q, S_K], axis=-1)
    pad = CONV_K // 2
    xbc = lax.conv_general_dilated(xbc, conv_w.astype(xbc.dtype)[:, None, :], (1,), [(pad, pad)],
                                   dimension_numbers=('NWC', 'WIO', 'NWC'),
                                   feature_group_count=CONV_DIM) + conv_b
    xbc = jax.nn.silu(xbc)
    xs, bm, cm = jnp.split(xbc, [SSD_WIDTH, SSD_WIDTH + SSD_GROUPS * D_STATE], axis=-1)
    xs = xs.reshape(b_, s_, SSD_GROUPS, SSD_HEADS_PER_GROUP, SSD_HEAD_DIM)
    bm = bm.reshape(b_, s_, SSD_GROUPS, D_STATE)
    cm = cm.reshape(b_, s_, SSD_GROUPS, D_STATE)
    dt = jax.nn.softplus(dt_raw.reshape(b_, s_, 2, SSD_GROUPS, SSD_HEADS_PER_GROUP)
                         + dt_bias.reshape(2, SSD_GROUPS, SSD_HEADS_PER_GROUP))
    a = -jnp.exp(a_log.astype(jnp.float32)).reshape(2, SSD_GROUPS, SSD_HEADS_PER_GROUP)
    y_fwd = _ssd_chunked(xs, dt[:, :, 0], a[0], bm, cm, strict=False)
    flip = lambda t: jnp.flip(t, axis=1)
    y_bwd = flip(_ssd_chunked(flip(xs), flip(dt[:, :, 1]), a[1], flip(bm), flip(cm), strict=True))
    y = y_fwd + y_bwd + xs * d_skip.reshape(SSD_GROUPS, SSD_HEADS_PER_GROUP)[:, :, None]
    y = y.reshape(b_, s_, SSD_WIDTH) * jax.nn.silu(z)
    y_ssd = _rms(y) * ssd_norm_w
    q = q.reshape(b_, s_, ATTN_HEADS, HEAD_DIM)
    k = k.reshape(b_, s_, ATTN_KV_HEADS, HEAD_DIM)
    v = v.reshape(b_, s_, ATTN_KV_HEADS, HEAD_DIM)
    q = _partial_rope(_rms(q) * q_norm_w, positions)
    k = _partial_rope(_rms(k) * k_norm_w, positions)
    q = q.reshape(b_, s_, ATTN_KV_HEADS, Q_PER_KV, HEAD_DIM)
    y_attn = _window_attention(q, k, v, sink_logit)
    return jnp.concatenate([y_ssd, y_attn], axis=-1) @ w_out


def setup_inputs(seed: int = 0) -> dict:
    key = jax.random.key(seed)
    ks = jax.random.split(key, 24)
    f32 = jnp.float32
    L = DEPTH

    def nrm(k, shape, s):
        return jax.random.normal(k, shape, f32) * s

    x = nrm(ks[0], (BATCH, SEQ, D_MODEL), 1.0)
    c = nrm(ks[1], (BATCH, D_MODEL), 1.0)
    positions = jnp.tile(jnp.arange(SEQ, dtype=jnp.int32)[None, :], (BATCH, 1))
    w_ada = nrm(ks[2], (L, D_MODEL, N_MOD * D_MODEL), 0.5 * D_MODEL ** -0.5)
    b_ada = nrm(ks[3], (L, N_MOD * D_MODEL), 0.01)
    norm_ffn1 = 1.0 + nrm(ks[4], (L, D_MODEL), 0.01)
    ffn1_wg = nrm(ks[5], (L, D_MODEL, D_FF), D_MODEL ** -0.5)
    ffn1_wu = nrm(ks[6], (L, D_MODEL, D_FF), D_MODEL ** -0.5)
    ffn1_wd = nrm(ks[7], (L, D_FF, D_MODEL), D_FF ** -0.5)
    norm_mix = 1.0 + nrm(ks[8], (L, D_MODEL), 0.01)
    w_in = nrm(ks[9], (L, D_MODEL, IN_WIDTH), D_MODEL ** -0.5)
    conv_w = nrm(ks[10], (L, CONV_K, CONV_DIM), CONV_K ** -0.5)
    conv_b = nrm(ks[11], (L, CONV_DIM), 0.01)
    dt0 = jnp.exp(jax.random.uniform(ks[12], (L, 2, SSD_HEADS), f32, math.log(DT_MIN), math.log(DT_MAX)))
    dt_bias = dt0 + jnp.log(-jnp.expm1(-dt0))
    a_log = jnp.log(jax.random.uniform(ks[13], (L, 2, SSD_HEADS), f32, A_MIN, A_MAX))
    d_skip = 1.0 + nrm(ks[14], (L, SSD_HEADS), 0.01)
    ssd_norm_w = 1.0 + nrm(ks[15], (L, SSD_WIDTH), 0.01)
    q_norm_w = 1.0 + nrm(ks[16], (L, HEAD_DIM), 0.01)
    k_norm_w = 1.0 + nrm(ks[17], (L, HEAD_DIM), 0.01)
    sink_logit = nrm(ks[18], (L, ATTN_HEADS), 0.5)
    w_out = nrm(ks[19], (L, MIX_WIDTH, D_MODEL), MIX_WIDTH ** -0.5)
    norm_ffn2 = 1.0 + nrm(ks[20], (L, D_MODEL), 0.01)
    ffn2_wg = nrm(ks[21], (L, D_MODEL, D_FF), D_MODEL ** -0.5)
    ffn2_wu = nrm(ks[22], (L, D_MODEL, D_FF), D_MODEL ** -0.5)
    ffn2_wd = nrm(ks[23], (L, D_FF, D_MODEL), D_FF ** -0.5)
    return {"x": x, "c": c, "positions": positions, "w_ada": w_ada, "b_ada": b_ada,
            "norm_ffn1": norm_ffn1, "ffn1_wg": ffn1_wg, "ffn1_wu": ffn1_wu, "ffn1_wd": ffn1_wd,
            "norm_mix": norm_mix, "w_in": w_in, "conv_w": conv_w, "conv_b": conv_b,
            "dt_bias": dt_bias, "a_log": a_log, "d_skip": d_skip, "ssd_norm_w": ssd_norm_w,
            "q_norm_w": q_norm_w, "k_norm_w": k_norm_w, "sink_logit": sink_logit, "w_out": w_out,
            "norm_ffn2": norm_ffn2, "ffn2_wg": ffn2_wg, "ffn2_wu": ffn2_wu, "ffn2_wd": ffn2_wd}


def reference(x, c, positions, w_ada, b_ada, norm_ffn1, ffn1_wg, ffn1_wu, ffn1_wd, norm_mix,
              w_in, conv_w, conv_b, dt_bias, a_log, d_skip, ssd_norm_w, q_norm_w, k_norm_w,
              sink_logit, w_out, norm_ffn2, ffn2_wg, ffn2_wu, ffn2_wd):
    h = x.astype(jnp.float32)
    cs = jax.nn.silu(c.astype(jnp.float32))
    b_ = c.shape[0]
    for l in range(DEPTH):
        mod = (cs @ w_ada[l] + b_ada[l]).reshape(b_, N_MOD, 1, D_MODEL)
        sh1, sc1, g1, sh2, sc2, g2, sh3, sc3, g3 = [mod[:, i] for i in range(N_MOD)]
        h = h + 0.5 * (1.0 + g1) * _swiglu(_ada_norm(h, norm_ffn1[l], sh1, sc1),
                                           ffn1_wg[l], ffn1_wu[l], ffn1_wd[l])
        u = _ada_norm(h, norm_mix[l], sh2, sc2)
        h = h + (1.0 + g2) * _token_mix(u, positions, w_in[l], conv_w[l], conv_b[l], dt_bias[l],
                                        a_log[l], d_skip[l], ssd_norm_w[l], q_norm_w[l],
                                        k_norm_w[l], sink_logit[l], w_out[l])
        h = h + 0.5 * (1.0 + g3) * _swiglu(_ada_norm(h, norm_ffn2[l], sh3, sc3),
                                           ffn2_wg[l], ffn2_wu[l], ffn2_wd[l])
    return h.astype(x.dtype)
```

```cpp
#include <hip/hip_runtime.h>
#include <hip/hip_cooperative_groups.h>
#include <cstdio>
#include <cstdint>
namespace cg = cooperative_groups;
namespace pg8 {
#define PG8_LAS __attribute__((address_space(3)))
typedef unsigned short bf16_t;
typedef short bf16x8 __attribute__((ext_vector_type(8)));
typedef float f32x4 __attribute__((ext_vector_type(4)));
typedef unsigned u32x4 __attribute__((ext_vector_type(4)));
constexpr int BM = 256, BK = 64, HALF = 128, HTB = HALF * BK * 2  , STAGE_BYTES = 8 * HTB, NXCD = 8, WGM = 2;

__host__ __device__ __forceinline__ int lds_byte(int r, int c) { const int st = (r >> 4) * 2 + (c >> 5), rr = r & 15, cc = c & 31, ob = rr * 64 + cc * 2; return st * 1024 + (ob ^ (((ob >> 9) & 1) << 5)); }
__host__ __device__ __forceinline__ void stage_rc(int b, int& R, int& C) { const int st = b / 1024, sb = b % 1024, swz = sb ^ (((sb >> 9) & 1) << 5); R = (st >> 1) * 16 + swz / 64; C = (st & 1) * 32 + (swz % 64) / 2; }
__host__ __device__ __forceinline__ int perm32(int rho) { const int n = rho >> 4, i = rho & 15; return 8 * (i >> 2) + 4 * n + (i & 3); }

struct Unit { int pm, pn; };
struct Gemm { const bf16_t* A; const bf16_t* Bt; int M, N, K; size_t bstep; int pmb; };

struct StaticOrder {
    int nM, nN, nwg, G, c, wgm;
    __host__ __device__ void init(int M, int N, int G_, int c_, int wgm_ = WGM) { nM = M / BM; nN = N / BM; nwg = nM * nN; G = G_; c = c_; wgm = wgm_; }
    __host__ __device__ bool next(int i, Unit& u) const {
        const long L = (long)i * G + c; if (L >= nwg) return false;
        int wgid = (int)L; { const int q = nwg / NXCD, r = nwg % NXCD, xcd = wgid % NXCD, off = wgid / NXCD; wgid = (xcd < r ? xcd * (q + 1) : r * (q + 1) + (xcd - r) * q) + off; }
        const int nig = wgm * nN, gid = wgid / nig, fm = gid * wgm, gsz = (nM - fm) < wgm ? (nM - fm) : wgm;
        u.pm = fm + ((wgid % nig) % gsz); u.pn = (wgid % nig) / gsz; return true;
    }
    __device__ __forceinline__ void a_ready(const Unit&) const {}
    __device__ __forceinline__ void done(const Unit&) const {}
};

__device__ __forceinline__ unsigned cvt_pk_bf16(float lo, float hi) { unsigned r; asm volatile("v_cvt_pk_bf16_f32 %0, %1, %2" : "=v"(r) : "v"(lo), "v"(hi)); return r; }
template <class Epi, class Sched, bool ALIGN_EPI = false, bool SP2 = false>
__device__ __forceinline__ void gemm_phase(PG8_LAS unsigned char* lds, const Gemm g, const Sched& S, const Epi& E) {
    const int tid = threadIdx.x, wid = __builtin_amdgcn_readfirstlane(tid >> 6), lane = tid & 63, wr = wid >> 2, wc = wid & 3, fr = lane & 15, fq = lane >> 4;
    const int K = g.K, nt = K / BK;
    unsigned voffA[2], voffB[2];
#pragma unroll
    for (int i = 0; i < 2; ++i) { int R, C; stage_rc(tid * 16 + i * 8192, R, C); const int Rb = Epi::PERM ? ((R & ~31) + perm32(R & 31)) : R;
        voffA[i] = (unsigned)(R * K + C) * 2u; voffB[i] = (unsigned)(Rb * K + C) * 2u; }
    const size_t kstep = (size_t)(BK * 2);
    const size_t hstep = (size_t)HALF * K * 2;
    const size_t tstep = 2 * hstep;
    const unsigned ldsw = (unsigned)wid * 1024u;
    const int aoff = lds_byte(wr * 64 + fr, fq * 8), boff = lds_byte(wc * 32 + fr, fq * 8);
#define PG8_SA(b, h) (((b) * 2 + (h)) * HTB)
#define PG8_SB(b, h) ((4 + (b) * 2 + (h)) * HTB)
#define PG8_STAGE(bufoff, gbase, voff) do { _Pragma("unroll") for (int _i = 0; _i < 2; ++_i) \
        __builtin_amdgcn_global_load_lds((const unsigned*)((const char*)(gbase) + (voff)[_i]), (PG8_LAS unsigned*)(lds + (bufoff) + ldsw + _i * 8192), 16, 0, 0); } while (0)
#define PG8_LDA(dst, b, h) do { _Pragma("unroll") for (int m = 0; m < 4; ++m) _Pragma("unroll") for (int k = 0; k < 2; ++k) dst[m][k] = *(const PG8_LAS bf16x8*)(lds + PG8_SA(b, h) + aoff + m * 2048 + k * 1024); } while (0)
#define PG8_LDB(dst, b, h) do { _Pragma("unroll") for (int n = 0; n < 2; ++n) _Pragma("unroll") for (int k = 0; k < 2; ++k) dst[n][k] = *(const PG8_LAS bf16x8*)(lds + PG8_SB(b, h) + boff + n * 2048 + k * 1024); } while (0)
#define PG8_MMA(ai, bj, At, Bt) do { __builtin_amdgcn_s_setprio(1); _Pragma("unroll") for (int m = 0; m < 4; ++m) _Pragma("unroll") for (int n = 0; n < 2; ++n) _Pragma("unroll") for (int k = 0; k < 2; ++k) \
        acc[ai][bj][m][n] = __builtin_amdgcn_mfma_f32_16x16x32_bf16(Bt[n][k], At[m][k], acc[ai][bj][m][n], 0, 0, 0); __builtin_amdgcn_s_setprio(0); } while (0)
#define PG8_WAIT_V(n) asm volatile("s_waitcnt vmcnt(" #n ")" ::: "memory")
#define PG8_WAIT_L(n) asm volatile("s_waitcnt lgkmcnt(" #n ")" ::: "memory")
#define PG8_BAR __builtin_amdgcn_s_barrier()
#define PG8_SCHED __builtin_amdgcn_sched_barrier(0)
    Unit cur, nxt; int ui = 0;
    if (!S.next(0, cur)) return;
    f32x4 acc[2][2][4][2];
#pragma unroll
    for (int a = 0; a < 2; ++a)
#pragma unroll
        for (int b = 0; b < 2; ++b)
#pragma unroll
            for (int m = 0; m < 4; ++m)
#pragma unroll
                for (int n = 0; n < 2; ++n) acc[a][b][m][n] = (f32x4){0.f, 0.f, 0.f, 0.f};
    bf16x8 At[4][2], B0[2][2], B1[2][2];
    const char* cA = (const char*)g.A + (size_t)cur.pm * tstep; const char* cB = (const char*)g.Bt + (size_t)cur.pn * tstep + (size_t)(cur.pm / g.pmb) * g.bstep;
    S.a_ready(cur);
    if constexpr (SP2) {
        PG8_STAGE(PG8_SB(0, 0), cB, voffB); PG8_STAGE(PG8_SB(0, 1), cB + hstep, voffB); PG8_STAGE(PG8_SA(0, 0), cA, voffA); PG8_STAGE(PG8_SA(0, 1), cA + hstep, voffA);
        if (wr == 1) PG8_BAR;
        PG8_WAIT_V(2); PG8_BAR;
        PG8_STAGE(PG8_SB(1, 0), cB + kstep, voffB); PG8_STAGE(PG8_SA(1, 0), cA + kstep, voffA); PG8_STAGE(PG8_SB(1, 1), cB + hstep + kstep, voffB);
        PG8_WAIT_V(6); PG8_BAR;
    } else {
        PG8_STAGE(PG8_SB(0, 0), cB, voffB); PG8_STAGE(PG8_SA(0, 0), cA, voffA); PG8_STAGE(PG8_SB(0, 1), cB + hstep, voffB); PG8_STAGE(PG8_SA(0, 1), cA + hstep, voffA);
        if (wr == 1) PG8_BAR;
        PG8_WAIT_V(4); PG8_BAR;
        PG8_STAGE(PG8_SB(1, 0), cB + kstep, voffB); PG8_STAGE(PG8_SA(1, 0), cA + kstep, voffA); PG8_STAGE(PG8_SB(1, 1), cB + hstep + kstep, voffB);
        PG8_WAIT_V(6); PG8_BAR;
    }
    for (;;) {
        const bool has_next = S.next(ui + 1, nxt);
        const char* nA = has_next ? (const char*)g.A + (size_t)nxt.pm * tstep : cA; const char* nB = has_next ? (const char*)g.Bt + (size_t)nxt.pn * tstep + (size_t)(nxt.pm / g.pmb) * g.bstep : cB;
        for (int t = 0; t < nt; t += 2) {
            const bool last = (t == nt - 2);
            const char* a1 = cA + (size_t)(t + 1) * kstep;
            const char* a2 = last ? nA : cA + (size_t)(t + 2) * kstep; const char* b2 = last ? nB : cB + (size_t)(t + 2) * kstep;
            const char* a3 = a2 + kstep; const char* b3 = b2 + kstep;
            if (last && has_next) S.a_ready(nxt);
            if constexpr (SP2) {
            PG8_LDB(B0, 0, 0); PG8_LDB(B1, 0, 1); PG8_SCHED; PG8_LDA(At, 0, 0); PG8_STAGE(PG8_SA(1, 1), a1 + hstep, voffA);
            PG8_WAIT_V(8); PG8_WAIT_L(0); PG8_BAR; PG8_MMA(0, 0, At, B0); PG8_MMA(0, 1, At, B1); PG8_BAR; PG8_SCHED;
            PG8_LDA(At, 0, 1); PG8_STAGE(PG8_SB(0, 0), b2, voffB); PG8_STAGE(PG8_SB(0, 1), b2 + hstep, voffB); PG8_STAGE(PG8_SA(0, 0), a2, voffA);
            PG8_WAIT_V(8); PG8_WAIT_L(0); PG8_BAR; PG8_MMA(1, 0, At, B0); PG8_MMA(1, 1, At, B1); PG8_BAR; PG8_SCHED;
            PG8_LDB(B0, 1, 0); PG8_LDB(B1, 1, 1); PG8_SCHED; PG8_LDA(At, 1, 0); PG8_STAGE(PG8_SA(0, 1), a2 + hstep, voffA);
            PG8_WAIT_V(8); PG8_WAIT_L(0); PG8_BAR; PG8_MMA(0, 0, At, B0); PG8_MMA(0, 1, At, B1); PG8_BAR; PG8_SCHED;
            PG8_LDA(At, 1, 1); PG8_STAGE(PG8_SB(1, 0), b3, voffB); PG8_STAGE(PG8_SB(1, 1), b3 + hstep, voffB); PG8_STAGE(PG8_SA(1, 0), a3, voffA);
            PG8_WAIT_V(8); PG8_WAIT_L(0); PG8_BAR; PG8_MMA(1, 0, At, B0); PG8_MMA(1, 1, At, B1); PG8_BAR; PG8_SCHED;
            } else {
            PG8_LDB(B0, 0, 0); PG8_SCHED; PG8_LDA(At, 0, 0); PG8_STAGE(PG8_SA(1, 1), a1 + hstep, voffA);
            PG8_WAIT_L(8); PG8_BAR; PG8_WAIT_L(0); PG8_MMA(0, 0, At, B0); PG8_BAR; PG8_SCHED;
            PG8_LDB(B1, 0, 1); PG8_STAGE(PG8_SB(0, 0), b2, voffB);
            PG8_BAR; PG8_WAIT_L(0); PG8_MMA(0, 1, At, B1); PG8_BAR;
            PG8_LDA(At, 0, 1); PG8_STAGE(PG8_SA(0, 0), a2, voffA);
            PG8_BAR; PG8_WAIT_L(0); PG8_MMA(1, 0, At, B0); PG8_BAR; PG8_SCHED;
            PG8_STAGE(PG8_SB(0, 1), b2 + hstep, voffB);
            PG8_WAIT_V(6); PG8_BAR; PG8_MMA(1, 1, At, B1); PG8_BAR;
            PG8_LDB(B0, 1, 0); PG8_SCHED; PG8_LDA(At, 1, 0); PG8_STAGE(PG8_SA(0, 1), a2 + hstep, voffA);
            PG8_WAIT_L(8); PG8_BAR; PG8_WAIT_L(0); PG8_MMA(0, 0, At, B0); PG8_BAR; PG8_SCHED;
            PG8_LDB(B1, 1, 1); PG8_STAGE(PG8_SB(1, 0), b3, voffB);
            PG8_BAR; PG8_WAIT_L(0); PG8_MMA(0, 1, At, B1); PG8_BAR;
            PG8_LDA(At, 1, 1); PG8_STAGE(PG8_SA(1, 0), a3, voffA);
            PG8_BAR; PG8_WAIT_L(0); PG8_MMA(1, 0, At, B0); PG8_BAR; PG8_SCHED;
            PG8_STAGE(PG8_SB(1, 1), b3 + hstep, voffB);
            PG8_WAIT_V(6); PG8_BAR; PG8_MMA(1, 1, At, B1); PG8_BAR;
            }
        }
        if constexpr (ALIGN_EPI) { if (wr == 0) PG8_BAR; }
        if constexpr (!Epi::AFTER_DRAIN) { E(acc, cur, wr, wc, fr, fq); S.done(cur); }
        if (!has_next) break;
#pragma unroll
        for (int a = 0; a < 2; ++a)
#pragma unroll
            for (int b = 0; b < 2; ++b)
#pragma unroll
                for (int m = 0; m < 4; ++m)
#pragma unroll
                    for (int n = 0; n < 2; ++n) acc[a][b][m][n] = (f32x4){0.f, 0.f, 0.f, 0.f};
        cur = nxt; cA = nA; cB = nB; ++ui;
        if constexpr (ALIGN_EPI) { if (wr == 1) PG8_BAR; }
    }
    PG8_WAIT_V(0);
    if constexpr (!ALIGN_EPI) { if (wr == 0) PG8_BAR; }
    PG8_BAR;
    if constexpr (Epi::AFTER_DRAIN) { E.fused(acc, cur, wr, wc, fr, fq, lds, wid, lane); S.done(cur); }
#undef PG8_SA
#undef PG8_SB
#undef PG8_STAGE
#undef PG8_LDA
#undef PG8_LDB
#undef PG8_MMA
#undef PG8_WAIT_V
#undef PG8_WAIT_L
#undef PG8_BAR
#undef PG8_SCHED
}
typedef __bf16 bf16x2_t __attribute__((ext_vector_type(2))); typedef float f32x2 __attribute__((ext_vector_type(2)));
__device__ __forceinline__ unsigned pk2(float lo, float hi) { f32x2 v = {lo, hi}; bf16x2_t b = __builtin_convertvector(v, bf16x2_t); return __builtin_bit_cast(unsigned, b); }
__device__ __forceinline__ float silu_f(float v) { return v * __builtin_amdgcn_rcpf(1.0f + __expf(-v)); }
template <bool FUSED> struct EpiSwiGLU {
    static constexpr bool PERM = true, AFTER_DRAIN = false;
    bf16_t* O; const float* rssq; const float* sW; int ldc; int sw_bstride; int rows_per_batch;
    __device__ __forceinline__ void operator()(const f32x4 (&acc)[2][2][4][2], const Unit& u, int wr, int wc, int fr, int fq) const {
        const int row0 = u.pm * BM + wr * 64 + fr, col0 = u.pn * HALF + wc * 32 + 8 * fq;
        f32x4 sg[2], su[2];
        if (FUSED) { const float* sp = sW + (size_t)((u.pm * BM) / rows_per_batch) * sw_bstride + u.pn * BM + wc * 32 + 8 * fq;
            sg[0] = *(const f32x4*)sp; sg[1] = *(const f32x4*)(sp + 4); su[0] = *(const f32x4*)(sp + HALF); su[1] = *(const f32x4*)(sp + HALF + 4); }
#pragma unroll
        for (int ai = 0; ai < 2; ++ai)
#pragma unroll
            for (int m = 0; m < 4; ++m) { bf16_t* rowp = O + (size_t)(row0 + ai * HALF + m * 16) * ldc + col0;
                f32x4 g0 = acc[ai][0][m][0], g1 = acc[ai][0][m][1], u0 = acc[ai][1][m][0], u1 = acc[ai][1][m][1];
                if (FUSED) { const float rs = rsqrtf(rssq[row0 + ai * HALF + m * 16] * (1.f / 1024.f) + 1e-6f); g0 = g0 * rs + sg[0]; g1 = g1 * rs + sg[1]; u0 = u0 * rs + su[0]; u1 = u1 * rs + su[1]; }
                u32x4 w; w.x = pk2(silu_f(g0[0]) * u0[0], silu_f(g0[1]) * u0[1]); w.y = pk2(silu_f(g0[2]) * u0[2], silu_f(g0[3]) * u0[3]);
                w.z = pk2(silu_f(g1[0]) * u1[0], silu_f(g1[1]) * u1[1]); w.w = pk2(silu_f(g1[2]) * u1[2], silu_f(g1[3]) * u1[3]);
                *(u32x4*)rowp = w; }
    }
};
template <bool BASE_BF16, bool OUT_BF16, bool RS = false, bool SSQ = false> struct EpiResid {
    static constexpr bool PERM = true, AFTER_DRAIN = false;
    const void* base; void* out; const float* gate; const float* rssq; float* ossq; int ldc; int gate_bstride; int rows_per_batch; float coef; float rs_inv_n;
    __device__ __forceinline__ void operator()(const f32x4 (&acc)[2][2][4][2], const Unit& u, int wr, int wc, int fr, int fq) const {
        const int row0 = u.pm * BM + wr * 64 + fr, col0 = u.pn * BM + wc * 32 + 8 * fq;
        const float* gp = gate + (size_t)((u.pm * BM) / rows_per_batch) * gate_bstride + col0;
        f32x4 gv[2][2];
#pragma unroll
        for (int bj = 0; bj < 2; ++bj)
#pragma unroll
            for (int n = 0; n < 2; ++n) gv[bj][n] = (*(const f32x4*)(gp + bj * HALF + n * 4) + 1.0f) * coef;
        constexpr int GB = BASE_BF16 ? 4 : 2;
#pragma unroll
        for (int gb = 0; gb < 8; gb += GB) {
            u32x4 braw[GB][2][BASE_BF16 ? 1 : 2];
#pragma unroll
            for (int q = 0; q < GB; ++q) { const int ai = (gb + q) >> 2, m = (gb + q) & 3; const size_t off = (size_t)(row0 + ai * HALF + m * 16) * ldc + col0;
#pragma unroll
                for (int bj = 0; bj < 2; ++bj) {
                    if (BASE_BF16) braw[q][bj][0] = *(const u32x4*)((const bf16_t*)base + off + bj * HALF);
                    else { braw[q][bj][0] = *(const u32x4*)((const float*)base + off + bj * HALF); braw[q][bj][BASE_BF16 ? 0 : 1] = *(const u32x4*)((const float*)base + off + bj * HALF + 4); } } }
#pragma unroll
            for (int q = 0; q < GB; ++q) { const int ai = (gb + q) >> 2, m = (gb + q) & 3; const size_t off = (size_t)(row0 + ai * HALF + m * 16) * ldc + col0;
                float rsc = 1.0f; if (RS) rsc = rsqrtf(rssq[row0 + ai * HALF + m * 16] * rs_inv_n + 1e-6f);
                float sq = 0.f;
#pragma unroll
                for (int bj = 0; bj < 2; ++bj) {
                    f32x4 b0, b1;
                    if (BASE_BF16) { const u32x4 w = braw[q][bj][0];
                        b0 = (f32x4){__uint_as_float(w.x << 16), __uint_as_float(w.x & 0xffff0000u), __uint_as_float(w.y << 16), __uint_as_float(w.y & 0xffff0000u)};
                        b1 = (f32x4){__uint_as_float(w.z << 16), __uint_as_float(w.z & 0xffff0000u), __uint_as_float(w.w << 16), __uint_as_float(w.w & 0xffff0000u)}; }
                    else { b0 = __builtin_bit_cast(f32x4, braw[q][bj][0]); b1 = __builtin_bit_cast(f32x4, braw[q][bj][BASE_BF16 ? 0 : 1]); }
                    f32x4 a0 = acc[ai][bj][m][0], a1 = acc[ai][bj][m][1]; if (RS) { a0 = a0 * rsc; a1 = a1 * rsc; }
                    const f32x4 o0 = b0 + a0 * gv[bj][0], o1 = b1 + a1 * gv[bj][1];
                    if (SSQ) sq += (o0[0] * o0[0] + o0[1] * o0[1]) + (o0[2] * o0[2] + o0[3] * o0[3]) + (o1[0] * o1[0] + o1[1] * o1[1]) + (o1[2] * o1[2] + o1[3] * o1[3]);
                    if (OUT_BF16) { u32x4 w; w.x = pk2(o0[0], o0[1]); w.y = pk2(o0[2], o0[3]); w.z = pk2(o1[0], o1[1]); w.w = pk2(o1[2], o1[3]); *(u32x4*)((bf16_t*)out + off + bj * HALF) = w; }
                    else { *(f32x4*)((float*)out + off + bj * HALF) = o0; *(f32x4*)((float*)out + off + bj * HALF + 4) = o1; }
                }
                if (SSQ) { sq += __shfl_xor(sq, 16); sq += __shfl_xor(sq, 32); if (fq == 0) __hip_atomic_fetch_add(ossq + row0 + ai * HALF + m * 16, sq, __ATOMIC_RELAXED, __HIP_MEMORY_SCOPE_AGENT); }
            }
            asm volatile("" ::: "memory");
        }
    }
};
struct EpiProj {
    static constexpr bool PERM = true, AFTER_DRAIN = false;
    bf16_t* O; float* DT; const float* dt_bias; const float* rssq; const float* sW; int ldc; int nfull; int sw_bstride; int rows_per_batch;
    __device__ __forceinline__ void operator()(const f32x4 (&acc)[2][2][4][2], const Unit& u, int wr, int wc, int fr, int fq) const {
        const int row0 = u.pm * BM + wr * 64 + fr;
        const float* sp = sW + (size_t)((u.pm * BM) / rows_per_batch) * sw_bstride + u.pn * BM + wc * 32 + 8 * fq;
        if (u.pn < nfull) {
            const int col0 = u.pn * BM + wc * 32 + 8 * fq;
            f32x4 sv[2][2];
#pragma unroll
            for (int bj = 0; bj < 2; ++bj) { sv[bj][0] = *(const f32x4*)(sp + bj * HALF); sv[bj][1] = *(const f32x4*)(sp + bj * HALF + 4); }
#pragma unroll
            for (int ai = 0; ai < 2; ++ai)
#pragma unroll
                for (int m = 0; m < 4; ++m) { bf16_t* rowp = O + (size_t)(row0 + ai * HALF + m * 16) * ldc + col0;
                    const float rs = rsqrtf(rssq[row0 + ai * HALF + m * 16] * (1.f / 1024.f) + 1e-6f);
#pragma unroll
                    for (int bj = 0; bj < 2; ++bj) { const f32x4 v0 = acc[ai][bj][m][0] * rs + sv[bj][0], v1 = acc[ai][bj][m][1] * rs + sv[bj][1];
                        u32x4 w; w.x = pk2(v0[0], v0[1]); w.y = pk2(v0[2], v0[3]); w.z = pk2(v1[0], v1[1]); w.w = pk2(v1[2], v1[3]);
                        *(u32x4*)(rowp + bj * HALF) = w; } }
        } else if (wc == 0 && fq < 2) {
            const f32x4 b0 = *(const f32x4*)(dt_bias + 8 * fq) + *(const f32x4*)sp, b1 = *(const f32x4*)(dt_bias + 8 * fq + 4) + *(const f32x4*)(sp + 4);
#pragma unroll
            for (int ai = 0; ai < 2; ++ai)
#pragma unroll
                for (int m = 0; m < 4; ++m) { float* rowp = DT + (size_t)(row0 + ai * HALF + m * 16) * 16 + 8 * fq;
                    const float rs = rsqrtf(rssq[row0 + ai * HALF + m * 16] * (1.f / 1024.f) + 1e-6f);
                    f32x4 v0 = acc[ai][0][m][0] * rs + b0, v1 = acc[ai][0][m][1] * rs + b1;
#pragma unroll
                    for (int j = 0; j < 4; ++j) { v0[j] = v0[j] > 20.f ? v0[j] : log1pf(__expf(v0[j])); v1[j] = v1[j] > 20.f ? v1[j] : log1pf(__expf(v1[j])); }
                    *(f32x4*)rowp = v0; *(f32x4*)(rowp + 4) = v1; }
        }
    }
};
struct EpiNull { static constexpr bool PERM = true, AFTER_DRAIN = false; float* sink;
    __device__ __forceinline__ void operator()(const f32x4 (&acc)[2][2][4][2], const Unit& u, int wr, int wc, int fr, int fq) const {
        f32x4 s = {0.f, 0.f, 0.f, 0.f};
#pragma unroll
        for (int ai = 0; ai < 2; ++ai)
#pragma unroll
            for (int bj = 0; bj < 2; ++bj)
#pragma unroll
                for (int m = 0; m < 4; ++m)
#pragma unroll
                    for (int n = 0; n < 2; ++n) s += acc[ai][bj][m][n];
        if (s[0] + s[1] + s[2] + s[3] == 123.456f) sink[0] = s[0]; }
};
}
#define GAS __attribute__((address_space(1)))
#define LAS __attribute__((address_space(3)))
typedef unsigned short bf16;
typedef unsigned v4u __attribute__((ext_vector_type(4)));
typedef unsigned v2u __attribute__((ext_vector_type(2)));
typedef float f32x4 __attribute__((ext_vector_type(4)));
typedef float f32x16 __attribute__((ext_vector_type(16)));
typedef short bf16x8 __attribute__((ext_vector_type(8)));
typedef short s16x4 __attribute__((ext_vector_type(4)));
typedef short v4i16_t __attribute__((ext_vector_type(4)));
using pg8::pk2; using pg8::silu_f;

constexpr int NWAVES = 8, NTHR = 512;
constexpr int D = 1024, BATCH = 4, SEQ = 8192, M = BATCH * SEQ;
constexpr int DFF = 2816, NGU = 2 * DFF;
constexpr int NPROJ = 2304, NPROJ_PAD = 2560, IN_WIDTH = 2320;
constexpr int PZ = 0, PXBC = 512, PQ = 1536, PK = 2048, PV = 2176;
constexpr int NCHUNK = 64, CH = 128;
constexpr int NMOD = 9 * D;
constexpr float EPS = 1e-6f;
constexpr float LOG2E = 1.4426950408889634f;
constexpr float QSCALE = 0.125f * LOG2E;

constexpr size_t MiB = 1u << 20;
constexpr size_t WS_CTL = 0, CTL_ZERO_BYTES = 1 * MiB;
constexpr size_t CTL_MOD = 65536, CTL_BAR = 16384, CTL_SSQ = 262144, CTL_RSSQ1 = 393216, CTL_RSSQ2 = 524288, CTL_SW2 = 655360, CTL_SW3 = 720896;
constexpr size_t WS_WGU1 = 2 * MiB, WS_WD1 = 13 * MiB, WS_WIN = 19 * MiB, WS_WOUT = 24 * MiB, WS_WGU2 = 26 * MiB, WS_WD2 = 37 * MiB;
constexpr size_t WS_DT = 43 * MiB, WS_CD = 45 * MiB;
constexpr size_t WS_U = 48 * MiB;
constexpr size_t WS_H = 112 * MiB;
constexpr size_t WS_WINB = 288 * MiB;
constexpr size_t WS_WGU2B = 308 * MiB;
constexpr size_t WS_X1 = 416 * MiB;
constexpr size_t WS_END = 480 * MiB;

constexpr int XS_PITCH = 528, BS_PITCH = 272, KV_PITCH = 144;
constexpr int L_XS = 0, L_BS = 128 * XS_PITCH, L_CS = L_BS + 128 * BS_PITCH, L_ARR = L_CS + 128 * BS_PITCH, L_END = L_ARR + 8192;
constexpr int LDS_BYTES = 152 * 1024;
static_assert(L_END + 64 <= LDS_BYTES && pg8::STAGE_BYTES <= LDS_BYTES, "LDS map");

struct Frame { LAS unsigned char* lds; int tid, lane, wave, vcu, G; };

__device__ __forceinline__ float bf_lo(unsigned w) { return __uint_as_float(w << 16); }
__device__ __forceinline__ float bf_hi(unsigned w) { return __uint_as_float(w & 0xffff0000u); }
__device__ __forceinline__ float wave_sum(float v) {
#pragma unroll
    for (int o = 1; o < 64; o <<= 1) v += __shfl_xor(v, o);
    return v;
}
#define LDS_WAIT() asm volatile("s_waitcnt lgkmcnt(0)" ::: "memory")
__device__ __forceinline__ f32x16 mfma32(bf16x8 a, bf16x8 b, f32x16 c) { return __builtin_amdgcn_mfma_f32_32x32x16_bf16(a, b, c, 0, 0, 0); }
__device__ __forceinline__ int crow(int reg, int h) { return (reg & 3) + 8 * (reg >> 2) + 4 * h; }
__device__ __forceinline__ bf16x8 frag_row(const LAS unsigned char* base, int pitch, int mn0, int k0, int lane) {
    return *(const LAS bf16x8*)(base + (mn0 + (lane & 31)) * pitch + (k0 + 8 * (lane >> 5)) * 2);
}
__device__ __forceinline__ s16x4 ds_tr(const LAS unsigned char* p) { return __builtin_bit_cast(s16x4, __builtin_amdgcn_ds_read_tr16_b64_v4i16((LAS v4i16_t*)p)); }
__device__ __forceinline__ bf16x8 frag_tr(const LAS unsigned char* base, int pitch, int kA, int kB, int mn0, int lane) {
    const int q4 = (lane & 15) >> 2, cb = (mn0 + 16 * ((lane >> 4) & 1) + 4 * (lane & 3)) * 2;
    const s16x4 a = ds_tr(base + (kA + q4) * pitch + cb), b = ds_tr(base + (kB + q4) * pitch + cb);
    bf16x8 r; r[0] = a[0]; r[1] = a[1]; r[2] = a[2]; r[3] = a[3]; r[4] = b[0]; r[5] = b[1]; r[6] = b[2]; r[7] = b[3]; return r;
}
__device__ __forceinline__ int perm_row(int m, int t) { return 32 * ((m >> 2) & 1) + 16 * t + 4 * (m >> 3) + (m & 3); }
__device__ __forceinline__ bf16x8 frag_tr_perm(const LAS unsigned char* base, int pitch, int kA, int kB, int mn_base, int t, int lane) {
    const int q4 = (lane & 15) >> 2, cb = (mn_base + 32 * (lane & 1) + 16 * t + 8 * ((lane >> 4) & 1) + 4 * ((lane >> 1) & 1)) * 2;
    const s16x4 a = ds_tr(base + (kA + q4) * pitch + cb), b2 = ds_tr(base + (kB + q4) * pitch + cb);
    bf16x8 r; r[0] = a[0]; r[1] = a[1]; r[2] = a[2]; r[3] = a[3]; r[4] = b2[0]; r[5] = b2[1]; r[6] = b2[2]; r[7] = b2[3]; return r;
}
__device__ __forceinline__ bf16x8 pack_step(const f32x16& x, int s) {
    v4u p; p.x = pk2(x[8 * s], x[8 * s + 1]); p.y = pk2(x[8 * s + 2], x[8 * s + 3]); p.z = pk2(x[8 * s + 4], x[8 * s + 5]); p.w = pk2(x[8 * s + 6], x[8 * s + 7]);
    return __builtin_bit_cast(bf16x8, p);
}

template <int MAP> __device__ __forceinline__ int map_row(int n) {
    if (MAP == 1) return 256 * (n >> 7) + (n & 127);
    if (MAP == 2) return 256 * (n >> 7) + 128 + (n & 127);
    if (MAP == 3) { if (n < 1536) return n; if (n < 1552) return NPROJ + (n - 1536); return n - 16; }
    return n;
}
template <int MAP>
__device__ __forceinline__ void transpose_item(const float* W, int K, int N, bf16* WT, LAS float* scr, int item, int lane) {
    const int nblk = (N + 31) / 32, kb = item / nblk, nb = item % nblk, k0 = 64 * kb, n0 = 32 * nb;
    const int nn = n0 + (lane & 31);
#pragma unroll
    for (int i = 0; i < 32; ++i) { const int kk = 2 * i + (lane >> 5); scr[kk * 33 + (lane & 31)] = nn < N ? W[(size_t)(k0 + kk) * N + nn] : 0.f; }
    LDS_WAIT(); asm volatile("" ::: "memory");
    const int c = lane & 7;
#pragma unroll
    for (int j = 0; j < 4; ++j) { const int n = (lane >> 3) + 8 * j; const LAS float* s = scr + (8 * c) * 33 + n;
        v4u o; o.x = pk2(s[0 * 33], s[1 * 33]); o.y = pk2(s[2 * 33], s[3 * 33]); o.z = pk2(s[4 * 33], s[5 * 33]); o.w = pk2(s[6 * 33], s[7 * 33]);
        if (n0 + n < N) *(v4u*)(WT + (size_t)map_row<MAP>(n0 + n) * K + k0 + 8 * c) = o; }
    LDS_WAIT(); asm volatile("" ::: "memory");
}
struct P0Args { const float *wg1, *wu1, *wd1, *wout, *wd2, *c, *wada, *bada; bf16 *WGU1, *WD1, *WOUT, *WD2; float* mod; };
__device__ __forceinline__ void p0_prologue(const Frame& F, const P0Args& A) {
    LAS float* scr = (LAS float*)(F.lds + F.wave * 16384);
    const int gw = F.vcu * NWAVES + F.wave, NGW = F.G * NWAVES;
    constexpr int I_GU = (D / 64) * (DFF / 32), I_D = (DFF / 64) * (D / 32), I_O = (D / 64) * (D / 32);
    constexpr int NITEMS = 2 * I_GU + 2 * I_D + I_O;
    for (int it = gw; it < NITEMS; it += NGW) {
        int r = it;
        if (r < I_GU) { transpose_item<1>(A.wg1, D, DFF, A.WGU1, scr, r, F.lane); continue; } r -= I_GU;
        if (r < I_GU) { transpose_item<2>(A.wu1, D, DFF, A.WGU1, scr, r, F.lane); continue; } r -= I_GU;
        if (r < I_D)  { transpose_item<0>(A.wd1, DFF, D, A.WD1, scr, r, F.lane); continue; } r -= I_D;
        if (r < I_D)  { transpose_item<0>(A.wd2, DFF, D, A.WD2, scr, r, F.lane); continue; } r -= I_D;
        transpose_item<0>(A.wout, D, D, A.WOUT, scr, r, F.lane);
    }
    constexpr int NCG = NMOD / 64, NKS = D / 64;
    for (int it = gw; it < NCG * NKS; it += NGW) {
        const int cgp = it % NCG, ks = it / NCG, n = cgp * 64 + F.lane, k0 = ks * 64;
        float s[4], acc[4] = {0.f, 0.f, 0.f, 0.f};
#pragma unroll
        for (int b = 0; b < 4; ++b) s[b] = silu_f(A.c[b * D + k0 + F.lane]);
        const float* wp = A.wada + (size_t)k0 * NMOD + n;
#pragma unroll 32
        for (int kk = 0; kk < 64; ++kk) { const float w = wp[(size_t)kk * NMOD];
#pragma unroll
            for (int b = 0; b < 4; ++b) acc[b] += w * __uint_as_float(__builtin_amdgcn_readlane(__float_as_uint(s[b]), kk)); }
        const float bias = ks == 0 ? A.bada[n] : 0.f;
#pragma unroll
        for (int b = 0; b < 4; ++b) __hip_atomic_fetch_add(A.mod + b * NMOD + n, acc[b] + bias, __ATOMIC_RELAXED, __HIP_MEMORY_SCOPE_AGENT);
    }
}

template <int MAP>
__device__ __forceinline__ void scale_item(const float* W, int K, int N, bf16* WB, size_t copy_stride, const float* gain, const float* mod, int i_shift, int i_scale, float* sW, int sw_stride, LAS float* scr, int item, int lane) {
    const int nblk = (N + 31) / 32, kb = item / nblk, nb = item % nblk, k0 = 64 * kb, n0 = 32 * nb;
    const int nn = n0 + (lane & 31);
#pragma unroll
    for (int i = 0; i < 32; ++i) { const int kk = 2 * i + (lane >> 5); scr[kk * 33 + (lane & 31)] = nn < N ? W[(size_t)(k0 + kk) * N + nn] : 0.f; }
    float gsv[4], shv[4];
    { const float gn = gain[k0 + lane];
#pragma unroll
      for (int b = 0; b < 4; ++b) { gsv[b] = gn * (1.0f + mod[b * NMOD + i_scale * D + k0 + lane]); shv[b] = mod[b * NMOD + i_shift * D + k0 + lane]; } }
    LDS_WAIT(); asm volatile("" ::: "memory");
    { float acc[4] = {0.f, 0.f, 0.f, 0.f};
#pragma unroll 16
      for (int kk = 0; kk < 64; ++kk) { const float w = scr[kk * 33 + (lane & 31)];
#pragma unroll
          for (int b = 0; b < 4; ++b) acc[b] += w * __uint_as_float(__builtin_amdgcn_readlane(__float_as_uint(shv[b]), kk)); }
      if (lane < 32 && nn < N) {
#pragma unroll
          for (int b = 0; b < 4; ++b) __hip_atomic_fetch_add(sW + b * sw_stride + map_row<MAP>(nn), acc[b], __ATOMIC_RELAXED, __HIP_MEMORY_SCOPE_AGENT); } }
    const int c = lane & 7;
#pragma unroll
    for (int b = 0; b < 4; ++b) {
        float gk[8];
#pragma unroll
        for (int jj = 0; jj < 8; ++jj) gk[jj] = __shfl(gsv[b], 8 * c + jj);
#pragma unroll
        for (int j = 0; j < 4; ++j) { const int n = (lane >> 3) + 8 * j; const LAS float* s = scr + (8 * c) * 33 + n;
            v4u o; o.x = pk2(s[0 * 33] * gk[0], s[1 * 33] * gk[1]); o.y = pk2(s[2 * 33] * gk[2], s[3 * 33] * gk[3]); o.z = pk2(s[4 * 33] * gk[4], s[5 * 33] * gk[5]); o.w = pk2(s[6 * 33] * gk[6], s[7 * 33] * gk[7]);
            if (n0 + n < N) *(v4u*)(WB + b * copy_stride + (size_t)map_row<MAP>(n0 + n) * K + k0 + 8 * c) = o; }
    }
    LDS_WAIT(); asm volatile("" ::: "memory");
}
struct PrepArgs { const float *win, *wg2, *wu2, *gain2, *gain3, *mod; bf16 *WINB, *WGU2B; float *sW2, *sW3; };
__device__ __forceinline__ void prep_phase(const Frame& F, const PrepArgs& A) {
    LAS float* scr = (LAS float*)(F.lds + F.wave * 16384);
    const int gw = F.vcu * NWAVES + F.wave, NGW = F.G * NWAVES;
    constexpr int I_GU = (D / 64) * (DFF / 32), I_IN = (D / 64) * ((IN_WIDTH + 31) / 32);
    for (int it = gw; it < 2 * I_GU + I_IN; it += NGW) {
        int r = it;
        if (r < I_IN) { scale_item<3>(A.win, D, IN_WIDTH, A.WINB, (size_t)NPROJ_PAD * D, A.gain2, A.mod, 3, 4, A.sW2, NPROJ_PAD, scr, r, F.lane); continue; } r -= I_IN;
        if (r < I_GU) { scale_item<1>(A.wg2, D, DFF, A.WGU2B, (size_t)NGU * D, A.gain3, A.mod, 6, 7, A.sW3, NGU, scr, r, F.lane); continue; } r -= I_GU;
        scale_item<2>(A.wu2, D, DFF, A.WGU2B, (size_t)NGU * D, A.gain3, A.mod, 6, 7, A.sW3, NGU, scr, r, F.lane);
    }
    { const int gt = (F.vcu * NTHR + F.tid), NT = F.G * NTHR; v4u z = {0u, 0u, 0u, 0u}; constexpr int PER = (NPROJ_PAD - IN_WIDTH) * D / 8;
      for (int i = gt; i < 4 * PER; i += NT) { const int b = i / PER, j = i % PER; *(v4u*)(A.WINB + (size_t)b * NPROJ_PAD * D + (size_t)IN_WIDTH * D + (size_t)j * 8) = z; } }
}

template <bool IN_BF16>
__device__ __forceinline__ void norm_phase(const Frame& F, const void* xin_, const float* gain, const float* mod, int i_shift, int i_scale, bf16* U) {
    const int gw = F.vcu * NWAVES + F.wave, NGW = F.G * NWAVES;
    for (int m0 = gw * 16; m0 < M; m0 += NGW * 16) {
        const int b = m0 / SEQ;
        f32x4 gs[4], sh[4];
#pragma unroll
        for (int j = 0; j < 4; ++j) { const int col = 4 * F.lane + 256 * j;
            const f32x4 g = *(const f32x4*)(gain + col), sc = *(const f32x4*)(mod + b * NMOD + i_scale * D + col);
            gs[j] = g * (sc + 1.0f); sh[j] = *(const f32x4*)(mod + b * NMOD + i_shift * D + col); }
        for (int r4 = 0; r4 < 16; r4 += 4) {
            f32x4 v[4][4]; float s[4];
#pragma unroll
            for (int q = 0; q < 4; ++q) {
                if (IN_BF16) { const v2u* xr = (const v2u*)((const bf16*)xin_ + (size_t)(m0 + r4 + q) * D) + F.lane;
#pragma unroll
                    for (int j = 0; j < 4; ++j) { const v2u w = xr[64 * j]; v[q][j] = (f32x4){bf_lo(w.x), bf_hi(w.x), bf_lo(w.y), bf_hi(w.y)}; } }
                else { const f32x4* xr = (const f32x4*)((const float*)xin_ + (size_t)(m0 + r4 + q) * D) + F.lane;
#pragma unroll
                    for (int j = 0; j < 4; ++j) v[q][j] = xr[64 * j]; } }
#pragma unroll
            for (int q = 0; q < 4; ++q) { s[q] = 0.f;
#pragma unroll
                for (int j = 0; j < 4; ++j) s[q] += (v[q][j].x * v[q][j].x + v[q][j].y * v[q][j].y) + (v[q][j].z * v[q][j].z + v[q][j].w * v[q][j].w); }
#pragma unroll
            for (int o = 1; o < 64; o <<= 1) {
#pragma unroll
                for (int q = 0; q < 4; ++q) s[q] += __shfl_xor(s[q], o); }
#pragma unroll
            for (int q = 0; q < 4; ++q) {
                const float rstd = rsqrtf(s[q] * (1.f / D) + EPS);
                v2u* o8 = (v2u*)(U + (size_t)(m0 + r4 + q) * D) + F.lane;
#pragma unroll
                for (int j = 0; j < 4; ++j) { const f32x4 o = v[q][j] * rstd * gs[j] + sh[j]; v2u w; w.x = pk2(o.x, o.y); w.y = pk2(o.z, o.w); o8[64 * j] = w; }
            }
        }
    }
}
typedef GAS unsigned gu32;
#define RLX_AGENT __ATOMIC_RELAXED, __HIP_MEMORY_SCOPE_AGENT
#define XB_TMO      128
#define XB_XCNT(j)  (256  + 64 * (j))
#define XB_XSUB(j)  (1280 + 64 * (j))
#define XB_XGEN(j)  (2304 + 64 * (j))
#define XB_TOP      3328
#define XB_TOPGEN   3392
#define XCD_BAR_WORDS 3456
#define XB_SPIN_CAP (1u << 18)

__device__ __forceinline__ unsigned xb_ld(unsigned* p)              { return __hip_atomic_load(p, __ATOMIC_RELAXED, __HIP_MEMORY_SCOPE_AGENT); }
__device__ __forceinline__ unsigned xb_add(unsigned* p, unsigned v) { return __hip_atomic_fetch_add(p, v, __ATOMIC_RELAXED, __HIP_MEMORY_SCOPE_AGENT); }
__device__ __forceinline__ unsigned xb_xcc_id() { return (unsigned)__builtin_amdgcn_s_getreg((3 << 11) | 20) & 0xFu; }
#define XB_SPIN(cond, bar) do { unsigned _sp = 0; while (cond) { __builtin_amdgcn_s_sleep(1); \
    if ((++_sp & 255u) == 0u) { if (xb_ld(&(bar)[XB_TMO])) break; if (_sp > XB_SPIN_CAP) { atomicAdd(&(bar)[XB_TMO], 1u); break; } } } } while (0)

struct XcdBarrier {
    unsigned* bar; unsigned x;
    volatile LAS unsigned* st;
};

__device__ __forceinline__ XcdBarrier xcd_barrier_post(unsigned* bar, volatile LAS unsigned* st) {
    XcdBarrier b; b.bar = bar; b.x = xb_xcc_id(); b.st = st;
    if (threadIdx.x == 0) (void)xb_add(&bar[XB_XCNT(b.x)], 1u);
    return b;
}
__device__ __forceinline__ void xcd_barrier_complete(unsigned* bar, unsigned x, unsigned& nloc, unsigned& nx) {
    const unsigned G = gridDim.x * gridDim.y * gridDim.z;
    unsigned sum, cnt, mine, sp = 0u;
    for (;;) {
        sum = 0u; cnt = 0u; mine = 0u;
#pragma unroll
        for (unsigned j = 0; j < 16; ++j) { const unsigned c = xb_ld(&bar[XB_XCNT(j)]); sum += c; cnt += (c > 0u) ? 1u : 0u; mine = (j == x) ? c : mine; }
        if (sum == G) break;
        __builtin_amdgcn_s_sleep(1);
        if ((++sp & 255u) == 0u) { if (xb_ld(&bar[XB_TMO])) break; if (sp > XB_SPIN_CAP) { atomicAdd(&bar[XB_TMO], 1u); break; } }
    }
    nloc = mine > 0u ? mine : 1u; nx = cnt > 0u ? cnt : 1u;
}

__device__ __forceinline__ void xcd_barrier(const XcdBarrier& b) {
    asm volatile("s_waitcnt vmcnt(0)" ::: "memory");
    __syncthreads();
    if (threadIdx.x == 0) {
        unsigned* bar = b.bar;
        __builtin_amdgcn_s_waitcnt(0);
        unsigned nloc = b.st[0], nx = b.st[1];
        if (nloc == 0u) { xcd_barrier_complete(bar, b.x, nloc, nx); b.st[0] = nloc; b.st[1] = nx; }
        const unsigned old = xb_add(&bar[XB_XSUB(b.x)], 1u);
        const unsigned gen = old / nloc;
        if (old + 1u == (gen + 1u) * nloc) {
            __builtin_amdgcn_fence(__ATOMIC_RELEASE, "agent");
            asm volatile("s_waitcnt vmcnt(0)" ::: "memory");
            const unsigned og = xb_add(&bar[XB_TOP], 1u);
            const unsigned tg = og / nx;
            if (og + 1u == (tg + 1u) * nx) xb_add(&bar[XB_TOPGEN], 1u);
            else XB_SPIN(xb_ld(&bar[XB_TOPGEN]) == tg, bar);
            __builtin_amdgcn_fence(__ATOMIC_ACQUIRE, "agent");
            xb_add(&bar[XB_XGEN(b.x)], 1u);
            asm volatile("s_waitcnt vmcnt(0)" ::: "memory");
        } else {
            XB_SPIN(xb_ld(&bar[XB_XGEN(b.x)]) == gen, bar);
            __builtin_amdgcn_fence(__ATOMIC_ACQUIRE, "agent");
            asm volatile("s_waitcnt vmcnt(0)" ::: "memory");
        }
    }
    __syncthreads();
}
struct ConvArgs { bf16* P; bf16* XBC; const float *conv_w, *conv_b, *qnw, *knw; const int* pos; };
__device__ __forceinline__ void cvt8(const v4u r, float (&f)[8]) { f[0] = bf_lo(r.x); f[1] = bf_hi(r.x); f[2] = bf_lo(r.y); f[3] = bf_hi(r.y); f[4] = bf_lo(r.z); f[5] = bf_hi(r.z); f[6] = bf_lo(r.w); f[7] = bf_hi(r.w); }
__device__ __forceinline__ void conv_phase(const Frame& F, const ConvArgs& A) {
    for (int item = F.vcu; item < BATCH * NCHUNK; item += F.G) {
        const int b = item / NCHUNK, c = item % NCHUNK;
        const size_t rowb = (size_t)b * SEQ;
        {
            const int cg8 = F.tid & 127, ch = cg8 * 8;
            float w[5][8], bias[8];
#pragma unroll
            for (int k = 0; k < 5; ++k) { const f32x4 a = *(const f32x4*)(A.conv_w + k * 1024 + ch), d = *(const f32x4*)(A.conv_w + k * 1024 + ch + 4);
                w[k][0] = a.x; w[k][1] = a.y; w[k][2] = a.z; w[k][3] = a.w; w[k][4] = d.x; w[k][5] = d.y; w[k][6] = d.z; w[k][7] = d.w; }
            { const f32x4 a = *(const f32x4*)(A.conv_b + ch), d = *(const f32x4*)(A.conv_b + ch + 4); bias[0] = a.x; bias[1] = a.y; bias[2] = a.z; bias[3] = a.w; bias[4] = d.x; bias[5] = d.y; bias[6] = d.z; bias[7] = d.w; }
#pragma unroll 1
            for (int it = 0; it < 4; ++it) {
                const int t0 = c * CH + ((F.tid >> 7) + 4 * it) * 8;
                v4u rows[12];
#pragma unroll
                for (int j = 0; j < 12; ++j) { const int t = t0 - 2 + j; rows[j] = (v4u){0u, 0u, 0u, 0u}; if (t >= 0 && t < SEQ) rows[j] = *(const v4u*)(A.P + (rowb + t) * NPROJ + PXBC + ch); }
#pragma unroll
                for (int i = 0; i < 8; ++i) {
                    float f0[8], f1[8], f2[8], f3[8], f4[8], o[8];
                    cvt8(rows[i], f0); cvt8(rows[i + 1], f1); cvt8(rows[i + 2], f2); cvt8(rows[i + 3], f3); cvt8(rows[i + 4], f4);
#pragma unroll
                    for (int j = 0; j < 8; ++j) { const float v = bias[j] + w[0][j] * f0[j] + w[1][j] * f1[j] + w[2][j] * f2[j] + w[3][j] * f3[j] + w[4][j] * f4[j]; o[j] = silu_f(v); }
                    v4u ov; ov.x = pk2(o[0], o[1]); ov.y = pk2(o[2], o[3]); ov.z = pk2(o[4], o[5]); ov.w = pk2(o[6], o[7]);
                    *(v4u*)(A.XBC + (rowb + t0 + i) * 1024 + ch) = ov;
                }
            }
        }
#pragma unroll 1
        for (int it4 = 0; it4 < 2; ++it4) {
            v4u raw[10];
#pragma unroll
            for (int u = 0; u < 10; ++u) { const int sidx = F.tid + NTHR * (10 * it4 + u), tok = sidx / 80, slot = sidx % 80; raw[u] = *(const v4u*)(A.P + (rowb + c * CH + tok) * NPROJ + PQ + slot * 8); }
#pragma unroll
            for (int u = 0; u < 10; ++u) {
                const int sidx = F.tid + NTHR * (10 * it4 + u), tok = sidx / 80, slot = sidx % 80, head = slot >> 3, part = slot & 7;
                const int t = c * CH + tok;
                bf16* p = A.P + (rowb + t) * NPROJ + PQ + slot * 8;
                float v[8]; cvt8(raw[u], v);
                float ss = 0.f;
#pragma unroll
                for (int j = 0; j < 8; ++j) ss += v[j] * v[j];
                ss += __shfl_xor(ss, 1); ss += __shfl_xor(ss, 2); ss += __shfl_xor(ss, 4);
                const float rstd = rsqrtf(ss * (1.f / 64.f) + EPS);
                const float* nw = (head < 8 ? A.qnw : A.knw) + part * 8;
                const f32x4 w0 = *(const f32x4*)nw, w1 = *(const f32x4*)(nw + 4);
                v[0] *= rstd * w0.x; v[1] *= rstd * w0.y; v[2] *= rstd * w0.z; v[3] *= rstd * w0.w; v[4] *= rstd * w1.x; v[5] *= rstd * w1.y; v[6] *= rstd * w1.z; v[7] *= rstd * w1.w;
                float oth[8];
#pragma unroll
                for (int j = 0; j < 8; ++j) oth[j] = __shfl_xor(v[j], 1);
                if (part < 2) {
                    const float posf = (float)A.pos[rowb + t];
                    const float sgn = part == 0 ? -1.f : 1.f;
                    const float inv[8] = {1.0f, 0.19392274f, 0.03760603f, 0.0072926646f, 0.0014142136f, 0.00027424819f, 5.3182957e-05f, 1.0313385e-05f};
#pragma unroll
                    for (int j = 0; j < 8; ++j) {
                        const float ang = posf * inv[j];
                        const float nrev = rintf(ang * 0.15915494309189535f);
                        float rr = fmaf(-nrev, 6.2831855f, ang); rr = fmaf(-nrev, -1.7484555e-7f, rr);
                        const float sn = __sinf(rr), cs = __cosf(rr);
                        v[j] = v[j] * cs + sgn * oth[j] * sn;
                    }
                }
                const float sc = head < 8 ? QSCALE : 1.0f;
                v4u ov; ov.x = pk2(v[0] * sc, v[1] * sc); ov.y = pk2(v[2] * sc, v[3] * sc); ov.z = pk2(v[4] * sc, v[5] * sc); ov.w = pk2(v[6] * sc, v[7] * sc);
                *(v4u*)p = ov;
            }
        }
    }
}
template <int NCOL>
__device__ __forceinline__ void stage_load(const Frame& F, v4u* tmp, const bf16* src, size_t row0, int src_pitch, int col0) {
    constexpr int CPR = NCOL / 8, PER = 128 * CPR / NTHR;
#pragma unroll
    for (int j = 0; j < PER; ++j) { const int i = F.tid + NTHR * j, r = i / CPR, cc = i % CPR; tmp[j] = *(const v4u*)(src + (row0 + r) * src_pitch + col0 + cc * 8); }
}
template <int NCOL>
__device__ __forceinline__ void stage_store(const Frame& F, const v4u* tmp, LAS unsigned char* dst, int dst_pitch) {
    constexpr int CPR = NCOL / 8, PER = 128 * CPR / NTHR;
#pragma unroll
    for (int j = 0; j < PER; ++j) { const int i = F.tid + NTHR * j, r = i / CPR, cc = i % CPR; *(LAS v4u*)(dst + r * dst_pitch + cc * 16) = tmp[j]; }
}
__device__ __forceinline__ void scan128(float& lo, float& hi, float& total, int lane) {
#pragma unroll
    for (int o = 1; o < 64; o <<= 1) { const float a = __shfl_up(lo, o), b2 = __shfl_up(hi, o); if (lane >= o) { lo += a; hi += b2; } }
    const float tl = __shfl(lo, 63); hi += tl; total = __shfl(hi, 63);
}
struct SsdArgs { const bf16* P; const bf16* XBC; const float* DT; const float *a_log, *d_skip, *ssd_nw; bf16* ST; float* CD; bf16* Y; float* ssq; };

__device__ __forceinline__ void ssd_states_phase(const Frame& F, const SsdArgs& A) {
    LAS unsigned char* Xs = F.lds + L_XS; LAS unsigned char* Bs = F.lds + L_BS; LAS float* wts = (LAS float*)(F.lds + L_ARR);
    const int lane = F.lane, h5 = lane >> 5;
    for (int item = F.vcu; item < BATCH * NCHUNK * 2; item += F.G) {
        const int g = item / (BATCH * NCHUNK), bc = item % (BATCH * NCHUNK), b = bc / NCHUNK, c = bc % NCHUNK;
        const size_t row0 = (size_t)b * SEQ + (size_t)c * CH;
        __syncthreads();
        const int hh = F.wave & 3, dir = F.wave >> 2, h = 4 * g + hh;
        const float dt0 = A.DT[(row0 + lane) * 16 + dir * 8 + h], dt1 = A.DT[(row0 + 64 + lane) * 16 + dir * 8 + h];
        {
            v4u tx[8], tb[4];
            stage_load<256>(F, tx, A.XBC, row0, 1024, g * 256); stage_load<128>(F, tb, A.XBC, row0, 1024, 512 + g * 128);
            stage_store<256>(F, tx, Xs, XS_PITCH); stage_store<128>(F, tb, Bs, BS_PITCH);
        }
        {
            const float a = -__expf(A.a_log[dir * 8 + h]);
            const float da0 = dt0 * a, da1 = dt1 * a;
            float p0 = da0, p1 = da1, tot; scan128(p0, p1, tot, lane);
            float w0, w1;
            if (dir == 0) { w0 = __expf(tot - p0) * dt0; w1 = __expf(tot - p1) * dt1; }
            else          { w0 = __expf(p0 - da0) * dt0; w1 = __expf(p1 - da1) * dt1; }
            wts[F.wave * 128 + lane] = w0; wts[F.wave * 128 + 64 + lane] = w1;
            if (lane == 0) A.CD[(bc * 2 + dir) * 8 + h] = __expf(tot);
        }
        __syncthreads();
        f32x16 acc[4][2];
#pragma unroll
        for (int nt = 0; nt < 4; ++nt)
#pragma unroll
            for (int pt = 0; pt < 2; ++pt)
#pragma unroll
                for (int r = 0; r < 16; ++r) acc[nt][pt][r] = 0.f;
#pragma unroll 2
        for (int ks = 0; ks < 8; ++ks) {
            const int s0 = 16 * ks + 8 * h5;
            const f32x4 wa = *(const LAS f32x4*)(wts + F.wave * 128 + s0), wb = *(const LAS f32x4*)(wts + F.wave * 128 + s0 + 4);
            const float wv[8] = {wa.x, wa.y, wa.z, wa.w, wb.x, wb.y, wb.z, wb.w};
            bf16x8 xb[2];
#pragma unroll
            for (int pt = 0; pt < 2; ++pt) {
                const bf16x8 raw = frag_tr(Xs, XS_PITCH, s0, s0 + 4, hh * 64 + 32 * pt, lane);
                v4u pk;
                pk.x = pk2(__uint_as_float(((unsigned)(unsigned short)raw[0]) << 16) * wv[0], __uint_as_float(((unsigned)(unsigned short)raw[1]) << 16) * wv[1]);
                pk.y = pk2(__uint_as_float(((unsigned)(unsigned short)raw[2]) << 16) * wv[2], __uint_as_float(((unsigned)(unsigned short)raw[3]) << 16) * wv[3]);
                pk.z = pk2(__uint_as_float(((unsigned)(unsigned short)raw[4]) << 16) * wv[4], __uint_as_float(((unsigned)(unsigned short)raw[5]) << 16) * wv[5]);
                pk.w = pk2(__uint_as_float(((unsigned)(unsigned short)raw[6]) << 16) * wv[6], __uint_as_float(((unsigned)(unsigned short)raw[7]) << 16) * wv[7]);
                xb[pt] = __builtin_bit_cast(bf16x8, pk);
            }
#pragma unroll
            for (int nt = 0; nt < 4; ++nt) {
                const bf16x8 bt = frag_tr_perm(Bs, BS_PITCH, s0, s0 + 4, 64 * (nt >> 1), nt & 1, lane);
#pragma unroll
                for (int pt = 0; pt < 2; ++pt) acc[nt][pt] = mfma32(bt, xb[pt], acc[nt][pt]);
            }
        }
        bf16* st = A.ST + ((size_t)((bc * 2 + dir) * 8 + h)) * 8192;
#pragma unroll
        for (int nt = 0; nt < 4; ++nt)
#pragma unroll
            for (int pt = 0; pt < 2; ++pt) { bf16* dst = st + (32 * pt + (lane & 31)) * 128 + 64 * (nt >> 1) + 32 * h5 + 16 * (nt & 1);
                v4u w0, w1; w0.x = pk2(acc[nt][pt][0], acc[nt][pt][1]); w0.y = pk2(acc[nt][pt][2], acc[nt][pt][3]); w0.z = pk2(acc[nt][pt][4], acc[nt][pt][5]); w0.w = pk2(acc[nt][pt][6], acc[nt][pt][7]);
                w1.x = pk2(acc[nt][pt][8], acc[nt][pt][9]); w1.y = pk2(acc[nt][pt][10], acc[nt][pt][11]); w1.z = pk2(acc[nt][pt][12], acc[nt][pt][13]); w1.w = pk2(acc[nt][pt][14], acc[nt][pt][15]);
                *(v4u*)dst = w0; *(v4u*)(dst + 8) = w1; }
    }
}

__device__ __forceinline__ void ssd_scan_phase(const Frame& F, const SsdArgs& A) {
    const int gt = F.vcu * NTHR + F.tid, NT = F.G * NTHR;
    for (int e = gt; e < BATCH * 2 * 8 * 64 * 32; e += NT) {
        const int n4 = e & 31, p = (e >> 5) & 63, h = (e >> 11) & 7, dir = (e >> 14) & 1, b = e >> 15;
        float st[4] = {0.f, 0.f, 0.f, 0.f};
        for (int c8 = 0; c8 < NCHUNK; c8 += 32) {
            v2u v[32]; float cd[32];
#pragma unroll
            for (int j = 0; j < 32; ++j) { const int c = dir == 0 ? (c8 + j) : (NCHUNK - 1 - c8 - j); const int bc = b * NCHUNK + c;
                v[j] = *(const v2u*)(A.ST + ((size_t)((bc * 2 + dir) * 8 + h)) * 8192 + p * 128 + 4 * n4); cd[j] = A.CD[(bc * 2 + dir) * 8 + h]; }
#pragma unroll
            for (int j = 0; j < 32; ++j) { const int c = dir == 0 ? (c8 + j) : (NCHUNK - 1 - c8 - j); const int bc = b * NCHUNK + c;
                v2u o; o.x = pk2(st[0], st[1]); o.y = pk2(st[2], st[3]);
                *(v2u*)(A.ST + ((size_t)((bc * 2 + dir) * 8 + h)) * 8192 + p * 128 + 4 * n4) = o;
                st[0] = st[0] * cd[j] + bf_lo(v[j].x); st[1] = st[1] * cd[j] + bf_hi(v[j].x); st[2] = st[2] * cd[j] + bf_lo(v[j].y); st[3] = st[3] * cd[j] + bf_hi(v[j].y); }
        }
    }
}
struct AttnArgs { const bf16* P; bf16* Y; const float* sink; const float *qnw, *knw; const float* ssq; };
__device__ __forceinline__ void attn_phase(const Frame& F, const AttnArgs& A) {
    LAS unsigned char* Ks = F.lds; LAS unsigned char* Vs = F.lds + 384 * KV_PITCH;
    const int lane = F.lane, h5 = lane >> 5, r32 = lane & 31;
    float mref;
    { float a = fabsf(A.qnw[lane]), b2 = fabsf(A.knw[lane]);
#pragma unroll
      for (int o = 1; o < 64; o <<= 1) { a = fmaxf(a, __shfl_xor(a, o)); b2 = fmaxf(b2, __shfl_xor(b2, o)); }
      mref = fminf(8.0f * LOG2E * a * b2 * 1.01f + 0.5f, 100.f); }
    v4u kt[6], vt[6];
    auto kv_fetch = [&](int item) {
        const int kvh = item / (BATCH * NCHUNK), bq = item % (BATCH * NCHUNK), b = bq / NCHUNK, qb = bq % NCHUNK; const size_t rowb = (size_t)b * SEQ;
#pragma unroll
        for (int jj = 0; jj < 6; ++jj) { const int i = F.tid + NTHR * jj, r = i >> 3, cc = i & 7, j = qb * 128 - 128 + r;
            kt[jj] = (v4u){0u, 0u, 0u, 0u}; vt[jj] = (v4u){0u, 0u, 0u, 0u};
            if (j >= 0 && j < SEQ) { const bf16* src = A.P + (rowb + j) * NPROJ + kvh * 64 + cc * 8; kt[jj] = *(const v4u*)(src + PK); vt[jj] = *(const v4u*)(src + PV); } }
    };
    if (F.vcu < BATCH * NCHUNK * 2) kv_fetch(F.vcu);
    for (int item = F.vcu; item < BATCH * NCHUNK * 2; item += F.G) {
        const int kvh = item / (BATCH * NCHUNK), bq = item % (BATCH * NCHUNK), b = bq / NCHUNK, qb = bq % NCHUNK;
        const size_t rowb = (size_t)b * SEQ;
        __syncthreads();
#pragma unroll
        for (int jj = 0; jj < 6; ++jj) { const int i = F.tid + NTHR * jj, r = i >> 3, cc = i & 7;
            *(LAS v4u*)(Ks + r * KV_PITCH + cc * 16) = kt[jj]; *(LAS v4u*)(Vs + r * KV_PITCH + cc * 16) = vt[jj]; }
        __syncthreads();
        if (item + F.G < BATCH * NCHUNK * 2) kv_fetch(item + F.G);
        const int hq = kvh * 4 + (F.wave & 3), qhalf = F.wave >> 2;
        const float sinkl = A.sink[hq] * LOG2E;
#pragma unroll 1
        for (int qt = 0; qt < 2; ++qt) {
            const int o = 64 * qhalf + 32 * qt;
            const int ir = o + r32;
            bf16x8 qf[4];
            { const bf16* qp = A.P + (rowb + qb * 128 + ir) * NPROJ + PQ + hq * 64 + 8 * h5;
#pragma unroll
              for (int kd = 0; kd < 4; ++kd) qf[kd] = *(const bf16x8*)(qp + 16 * kd); }
            float lsum = h5 == 0 ? __builtin_amdgcn_exp2f(sinkl - mref) : 0.0f;
            f32x16 oacc[2];
#pragma unroll
            for (int r = 0; r < 16; ++r) { oacc[0][r] = 0.f; oacc[1][r] = 0.f; }
#pragma unroll 1
            for (int ks = 0; ks < 6; ++ks) {
                const int kstart = -128 + 64 * ks;
                if (kstart > o + 31 + 128 || kstart + 63 < o - 128) continue;
                f32x16 st[2];
#pragma unroll
                for (int kt = 0; kt < 2; ++kt) {
#pragma unroll
                    for (int r = 0; r < 16; ++r) st[kt][r] = -mref;
#pragma unroll
                    for (int kd = 0; kd < 4; ++kd) st[kt] = mfma32(frag_row(Ks, KV_PITCH, 64 * ks + 32 * kt, 16 * kd, lane), qf[kd], st[kt]);
                }
                const bool interior = (kstart >= o + 31 - 128) && (kstart + 63 <= o + 128) && (qb * 128 + kstart >= 0) && (qb * 128 + kstart + 63 < SEQ);
                if (!interior) {
#pragma unroll
                    for (int kt = 0; kt < 2; ++kt)
#pragma unroll
                        for (int r = 0; r < 16; ++r) { const int jr = kstart + 32 * kt + crow(r, h5); const int dlt = ir - jr; const int jg = qb * 128 + jr;
                            const bool ok = dlt <= 128 && dlt >= -128 && jg >= 0 && jg < SEQ;
                            st[kt][r] = ok ? st[kt][r] : -1e30f; }
                }
                float ps = 0.f;
#pragma unroll
                for (int kt = 0; kt < 2; ++kt)
#pragma unroll
                    for (int r = 0; r < 16; ++r) { const float p = __builtin_amdgcn_exp2f(st[kt][r]); st[kt][r] = p; ps += p; }
                lsum += ps;
#pragma unroll
                for (int kt = 0; kt < 2; ++kt)
#pragma unroll
                    for (int s2 = 0; s2 < 2; ++s2) {
                        const bf16x8 pf = pack_step(st[kt], s2);
                        const int key0 = 64 * ks + 32 * kt + 16 * s2 + 4 * h5;
#pragma unroll
                        for (int dt = 0; dt < 2; ++dt) oacc[dt] = mfma32(frag_tr_perm(Vs, KV_PITCH, key0, key0 + 8, 0, dt, lane), pf, oacc[dt]);
                    }
            }
            lsum += __shfl_xor(lsum, 32);
            const float inv = sqrtf(__hip_atomic_load(A.ssq + rowb + qb * 128 + ir, __ATOMIC_RELAXED, __HIP_MEMORY_SCOPE_AGENT) * (1.f / 512.f) + EPS) / lsum;
            bf16* yp = A.Y + (rowb + qb * 128 + ir) * 1024 + 512 + hq * 64 + 32 * h5;
#pragma unroll
            for (int dt = 0; dt < 2; ++dt) {
                v4u w0, w1; w0.x = pk2(oacc[dt][0] * inv, oacc[dt][1] * inv); w0.y = pk2(oacc[dt][2] * inv, oacc[dt][3] * inv); w0.z = pk2(oacc[dt][4] * inv, oacc[dt][5] * inv); w0.w = pk2(oacc[dt][6] * inv, oacc[dt][7] * inv);
                w1.x = pk2(oacc[dt][8] * inv, oacc[dt][9] * inv); w1.y = pk2(oacc[dt][10] * inv, oacc[dt][11] * inv); w1.z = pk2(oacc[dt][12] * inv, oacc[dt][13] * inv); w1.w = pk2(oacc[dt][14] * inv, oacc[dt][15] * inv);
                *(v4u*)(yp + 16 * dt) = w0; *(v4u*)(yp + 16 * dt + 8) = w1; }
        }
    }
}
__device__ __forceinline__ void ssd_out_phase(const Frame& F, const SsdArgs& A) {
    LAS unsigned char* Xs = F.lds + L_XS; LAS unsigned char* Bs = F.lds + L_BS; LAS unsigned char* Cs = F.lds + L_CS;
    LAS float* arr = (LAS float*)(F.lds + L_ARR);
    const int lane = F.lane, h5 = lane >> 5, r32 = lane & 31;
    const int hh = F.wave & 3, lhalf = F.wave >> 2;
    for (int item = F.vcu; item < BATCH * NCHUNK * 2; item += F.G) {
        const int g = item / (BATCH * NCHUNK), bc = item % (BATCH * NCHUNK), b = bc / NCHUNK, c = bc % NCHUNK;
        const size_t row0 = (size_t)b * SEQ + (size_t)c * CH;
        const int h = 4 * g + hh;
        __syncthreads();
        {
            const int dir = F.wave >> 2;
            const float dt0 = A.DT[(row0 + lane) * 16 + dir * 8 + h], dt1 = A.DT[(row0 + 64 + lane) * 16 + dir * 8 + h];
            {
                v4u tx[8], tb[4], tc[4];
                stage_load<256>(F, tx, A.XBC, row0, 1024, g * 256); stage_load<128>(F, tb, A.XBC, row0, 1024, 512 + g * 128); stage_load<128>(F, tc, A.XBC, row0, 1024, 768 + g * 128);
                stage_store<256>(F, tx, Xs, XS_PITCH); stage_store<128>(F, tb, Bs, BS_PITCH); stage_store<128>(F, tc, Cs, BS_PITCH);
            }
            const float a = -__expf(A.a_log[dir * 8 + h]);
            const float da0 = dt0 * a, da1 = dt1 * a;
            float p0 = da0, p1 = da1, tot; scan128(p0, p1, tot, lane);
            LAS float* cs = arr + (2 * dir) * 512 + hh * 128; LAS float* dts = arr + (2 * dir + 1) * 512 + hh * 128;
            if (dir == 0) { cs[lane] = p0; cs[64 + lane] = p1; } else { cs[lane] = tot - p0 + da0; cs[64 + lane] = tot - p1 + da1; }
            dts[lane] = dt0; dts[64 + lane] = dt1;
        }
        __syncthreads();
        const float dsk = A.d_skip[h];
        const LAS float* csf = arr + hh * 128; const LAS float* dtf = arr + 512 + hh * 128; const LAS float* rsb = arr + 1024 + hh * 128; const LAS float* dtb = arr + 1536 + hh * 128;
#pragma unroll 1
        for (int lt2 = 0; lt2 < 2; ++lt2) {
            const int lt = 2 * lhalf + lt2, l = 32 * lt + r32;
            const float my_cs = csf[l], my_rs = rsb[l];
            const int ch0 = h * 64 + 32 * h5;
            v4u zz[4];
            { const bf16* zp = A.P + (row0 + l) * NPROJ + PZ + ch0;
#pragma unroll
              for (int q = 0; q < 4; ++q) zz[q] = *(const v4u*)(zp + 8 * q); }
            f32x16 yacc[2];
#pragma unroll
            for (int r = 0; r < 16; ++r) { yacc[0][r] = 0.f; yacc[1][r] = 0.f; }
            bf16x8 cf[8];
#pragma unroll
            for (int kn = 0; kn < 8; ++kn) cf[kn] = frag_row(Cs, BS_PITCH, 32 * lt, 16 * kn, lane);
#pragma unroll 1
            for (int st = 0; st < 4; ++st) {
                f32x16 cbt;
#pragma unroll
                for (int r = 0; r < 16; ++r) cbt[r] = 0.f;
#pragma unroll
                for (int kn = 0; kn < 8; ++kn) cbt = mfma32(frag_row(Bs, BS_PITCH, 32 * st, 16 * kn, lane), cf[kn], cbt);
#pragma unroll
                for (int g4 = 0; g4 < 4; ++g4) {
                    const int sb = 32 * st + 8 * g4 + 4 * h5;
                    const f32x4 c4 = *(const LAS f32x4*)(csf + sb), d4 = *(const LAS f32x4*)(dtf + sb), r4 = *(const LAS f32x4*)(rsb + sb), e4 = *(const LAS f32x4*)(dtb + sb);
#pragma unroll
                    for (int i = 0; i < 4; ++i) { const int s = sb + i; const bool fwd = s <= l;
                        const float e = fwd ? (my_cs - c4[i]) : (my_rs - r4[i]); const float dtv = fwd ? d4[i] : e4[i];
                        float mval = cbt[4 * g4 + i] * __expf(e) * dtv; if (s == l) mval += dsk; cbt[4 * g4 + i] = mval; }
                }
#pragma unroll
                for (int s2 = 0; s2 < 2; ++s2) {
                    const bf16x8 mf = pack_step(cbt, s2);
                    const int sA = 32 * st + 16 * s2 + 4 * h5;
#pragma unroll
                    for (int pt = 0; pt < 2; ++pt) yacc[pt] = mfma32(frag_tr_perm(Xs, XS_PITCH, sA, sA + 8, hh * 64, pt, lane), mf, yacc[pt]);
                }
            }
#pragma unroll 1
            for (int dir = 0; dir < 2; ++dir) {
                const bf16* stp = A.ST + ((size_t)((bc * 2 + dir) * 8 + h)) * 8192 + 8 * h5;
                bf16x8 sf[2][8];
#pragma unroll
                for (int pt = 0; pt < 2; ++pt)
#pragma unroll
                    for (int kn = 0; kn < 8; ++kn) sf[pt][kn] = *(const bf16x8*)(stp + perm_row(r32, pt) * 128 + 16 * kn);
                const float ef = __expf(dir == 0 ? my_cs : my_rs);
#pragma unroll
                for (int kn = 0; kn < 8; ++kn) {
                    const v4u cw = __builtin_bit_cast(v4u, cf[kn]);
                    v4u sw; sw.x = pk2(bf_lo(cw.x) * ef, bf_hi(cw.x) * ef); sw.y = pk2(bf_lo(cw.y) * ef, bf_hi(cw.y) * ef); sw.z = pk2(bf_lo(cw.z) * ef, bf_hi(cw.z) * ef); sw.w = pk2(bf_lo(cw.w) * ef, bf_hi(cw.w) * ef);
                    const bf16x8 cs8 = __builtin_bit_cast(bf16x8, sw);
#pragma unroll
                    for (int pt = 0; pt < 2; ++pt) yacc[pt] = mfma32(sf[pt][kn], cs8, yacc[pt]);
                }
            }
            {
                bf16* yp = A.Y + (row0 + l) * 1024 + ch0;
                float sq = 0.f;
#pragma unroll
                for (int q = 0; q < 4; ++q) {
                    const int pt = q >> 1, r0 = 8 * (q & 1);
                    const f32x4 nw0 = *(const f32x4*)(A.ssd_nw + ch0 + 8 * q), nw1 = *(const f32x4*)(A.ssd_nw + ch0 + 8 * q + 4);
                    float zf[8]; cvt8(zz[q], zf);
                    float y[8];
#pragma unroll
                    for (int i = 0; i < 8; ++i) { y[i] = yacc[pt][r0 + i] * silu_f(zf[i]); sq += y[i] * y[i]; }
                    v4u w; w.x = pk2(y[0] * nw0.x, y[1] * nw0.y); w.y = pk2(y[2] * nw0.z, y[3] * nw0.w); w.z = pk2(y[4] * nw1.x, y[5] * nw1.y); w.w = pk2(y[6] * nw1.z, y[7] * nw1.w);
                    *(v4u*)(yp + 8 * q) = w;
                }
                sq += __shfl_xor(sq, 32);
                if (h5 == 0) __hip_atomic_fetch_add(A.ssq + row0 + l, sq, __ATOMIC_RELAXED, __HIP_MEMORY_SCOPE_AGENT);
            }
        }
    }
}
#ifndef MK_ONE_LAUNCH
#define MK_ONE_LAUNCH 1
#endif
constexpr int NPHASE = 11;
struct Args { const float* in[25]; float* out; unsigned char* ws; int ph_lo, ph_hi; };
__global__ void __launch_bounds__(NTHR, 2) hybrid_fwd(Args args) {
    extern __shared__ __attribute__((aligned(16))) unsigned char lds_raw[];
    Frame F;
    F.lds = (LAS unsigned char*)lds_raw;
    F.tid = threadIdx.x; F.lane = F.tid & 63; F.wave = __builtin_amdgcn_readfirstlane(F.tid >> 6);
    F.G = gridDim.x; { const int bx = blockIdx.x; F.vcu = (F.G % 8 == 0) ? (bx % 8) * (F.G / 8) + bx / 8 : bx; }
    unsigned char* ws = args.ws;
    const float* x = args.in[0]; const float* cvec = args.in[1]; const int* pos = (const int*)args.in[2];
    const float *w_ada = args.in[3], *b_ada = args.in[4], *norm_ffn1 = args.in[5], *ffn1_wg = args.in[6], *ffn1_wu = args.in[7], *ffn1_wd = args.in[8], *norm_mix = args.in[9], *w_in = args.in[10];
    const float *conv_w = args.in[11], *conv_b = args.in[12], *dt_bias = args.in[13], *a_log = args.in[14], *d_skip = args.in[15], *ssd_nw = args.in[16], *qnw = args.in[17], *knw = args.in[18], *sink = args.in[19];
    const float *w_out = args.in[20], *norm_ffn2 = args.in[21], *ffn2_wg = args.in[22], *ffn2_wu = args.in[23], *ffn2_wd = args.in[24];
    float* out = args.out;
    float* mod = (float*)(ws + WS_CTL + CTL_MOD);
    bf16 *WGU1 = (bf16*)(ws + WS_WGU1), *WD1 = (bf16*)(ws + WS_WD1), *WINB = (bf16*)(ws + WS_WINB), *WOUT = (bf16*)(ws + WS_WOUT), *WGU2B = (bf16*)(ws + WS_WGU2B), *WD2 = (bf16*)(ws + WS_WD2);
    float* DT = (float*)(ws + WS_DT); float* CD = (float*)(ws + WS_CD); float* ssq = (float*)(ws + WS_CTL + CTL_SSQ); float* rssq1 = (float*)(ws + WS_CTL + CTL_RSSQ1); float* rssq2 = (float*)(ws + WS_CTL + CTL_RSSQ2); float* sW2 = (float*)(ws + WS_CTL + CTL_SW2); float* sW3 = (float*)(ws + WS_CTL + CTL_SW3);
    bf16 *U = (bf16*)(ws + WS_U), *H = (bf16*)(ws + WS_H), *P = (bf16*)(ws + WS_H), *XBC = (bf16*)out, *ST = (bf16*)out + (size_t)M * 1024, *X1 = (bf16*)(ws + WS_X1);
    const int lo = args.ph_lo, hi = args.ph_hi;
    cg::grid_group grid = cg::this_grid();
    volatile LAS unsigned* xbst = (volatile LAS unsigned*)(F.lds + L_END);
    if (F.tid < 2) xbst[F.tid] = 0u;
    __syncthreads();
    XcdBarrier bar; bar.bar = (unsigned*)(ws + WS_CTL + CTL_BAR); bar.x = 0; bar.st = xbst;
    if (hi - lo > 1) bar = xcd_barrier_post((unsigned*)(ws + WS_CTL + CTL_BAR), xbst);
#ifndef PHM
#define PHM 0xffff
#endif
#ifndef WGM_N4
#define WGM_N4 2
#endif
#ifndef EPI_ALIGN
#define EPI_ALIGN true
#endif
#ifndef DUPM
#define DUPM 0
#endif
#define IN(k) (((PHM >> (k)) & 1) && lo <= (k) && (k) < hi)
#define SEAM(k) do { if (IN(k) && IN((k) + 1)) xcd_barrier(bar); } while (0)
#define DUP(k) (((DUPM >> (k)) & 1) != 0)
#define PHASE(k, ...) if (IN(k)) { __VA_ARGS__; if (DUP(k)) { xcd_barrier(bar); __VA_ARGS__; } } SEAM(k);
    if (lo > hi) grid.sync();
    PHASE(0, { P0Args A{ffn1_wg, ffn1_wu, ffn1_wd, w_out, ffn2_wd, cvec, w_ada, b_ada, WGU1, WD1, WOUT, WD2, mod}; p0_prologue(F, A); })
    PHASE(1, { norm_phase<false>(F, x, norm_ffn1, mod, 0, 1, U); PrepArgs A{w_in, ffn2_wg, ffn2_wu, norm_mix, norm_ffn2, mod, WINB, WGU2B, sW2, sW3}; prep_phase(F, A); })
    PHASE(2, { pg8::Gemm g{U, WGU1, M, NGU, D, 0, 1 << 30}; pg8::StaticOrder S; S.init(M, NGU, F.G, (int)blockIdx.x); pg8::EpiSwiGLU<false> E{H, nullptr, nullptr, DFF, 0, SEQ};
        pg8::gemm_phase<pg8::EpiSwiGLU<false>, pg8::StaticOrder, true, true>(F.lds, g, S, E); })
    PHASE(3, { pg8::Gemm g{H, WD1, M, D, DFF, 0, 1 << 30}; pg8::StaticOrder S; S.init(M, D, F.G, (int)blockIdx.x, WGM_N4); pg8::EpiResid<false, true, false, true> E{x, X1, mod + 2 * D, nullptr, rssq1, D, NMOD, SEQ, 0.5f, 0.f};
        pg8::gemm_phase<pg8::EpiResid<false, true, false, true>, pg8::StaticOrder, EPI_ALIGN, true>(F.lds, g, S, E); })
    PHASE(4, { pg8::Gemm g{X1, WINB, M, NPROJ_PAD, D, (size_t)NPROJ_PAD * D * 2, SEQ / 256}; pg8::StaticOrder S; S.init(M, NPROJ_PAD, F.G, (int)blockIdx.x); pg8::EpiProj E{P, DT, dt_bias, rssq1, sW2, NPROJ, NPROJ / 256, NPROJ_PAD, SEQ};
        pg8::gemm_phase<pg8::EpiProj, pg8::StaticOrder, true, true>(F.lds, g, S, E); })
    PHASE(5, { ConvArgs A{P, XBC, conv_w, conv_b, qnw, knw, pos}; conv_phase(F, A); if (F.G != BATCH * NCHUNK) xcd_barrier(bar); else __syncthreads();
               SsdArgs B{P, XBC, DT, a_log, d_skip, ssd_nw, ST, CD, U, ssq}; ssd_states_phase(F, B); })
    PHASE(6, { SsdArgs A{P, XBC, DT, a_log, d_skip, ssd_nw, ST, CD, U, ssq}; ssd_scan_phase(F, A); })
    PHASE(7, { SsdArgs A{P, XBC, DT, a_log, d_skip, ssd_nw, ST, CD, U, ssq}; ssd_out_phase(F, A); if (F.G != BATCH * NCHUNK) xcd_barrier(bar); else __syncthreads();
               AttnArgs B{P, U, sink, qnw, knw, ssq}; attn_phase(F, B); })
    PHASE(8, { pg8::Gemm g{U, WOUT, M, D, D, 0, 1 << 30}; pg8::StaticOrder S; S.init(M, D, F.G, (int)blockIdx.x, WGM_N4); pg8::EpiResid<true, true, true, true> E{X1, X1, mod + 5 * D, ssq, rssq2, D, NMOD, SEQ, 1.0f, 1.f / 512.f};
        pg8::gemm_phase<pg8::EpiResid<true, true, true, true>, pg8::StaticOrder, EPI_ALIGN, true>(F.lds, g, S, E); })
    PHASE(9, { pg8::Gemm g{X1, WGU2B, M, NGU, D, (size_t)NGU * D * 2, SEQ / 256}; pg8::StaticOrder S; S.init(M, NGU, F.G, (int)blockIdx.x); pg8::EpiSwiGLU<true> E{H, rssq2, sW3, DFF, NGU, SEQ};
        pg8::gemm_phase<pg8::EpiSwiGLU<true>, pg8::StaticOrder, true, true>(F.lds, g, S, E); })
    PHASE(10, { pg8::Gemm g{H, WD2, M, D, DFF, 0, 1 << 30}; pg8::StaticOrder S; S.init(M, D, F.G, (int)blockIdx.x, WGM_N4); pg8::EpiResid<true, false> E{X1, out, mod + 8 * D, nullptr, nullptr, D, NMOD, SEQ, 0.5f, 0.f};
        pg8::gemm_phase<pg8::EpiResid<true, false>, pg8::StaticOrder, EPI_ALIGN, true>(F.lds, g, S, E); })
#undef IN
#undef SEAM
}

extern "C" void kernel_launch(void* const* d_in, const int* in_sizes, int n_in, void* d_out, int out_size, void* d_ws, size_t ws_size, hipStream_t stream) {
    static int grid = 0;
    if (grid == 0) {
        if (n_in != 25 || in_sizes[0] != M * D || out_size != M * D || ws_size < WS_END) { fprintf(stderr, "kernel_launch: unexpected shapes (n_in %d, in0 %d, out %d, ws %zu)\n", n_in, n_in > 0 ? in_sizes[0] : -1, out_size, ws_size); grid = -1; return; }
        int dev = 0, cus = 0, per_cu = 0;
        if (hipGetDevice(&dev) != hipSuccess || hipDeviceGetAttribute(&cus, hipDeviceAttributeMultiprocessorCount, dev) != hipSuccess) { grid = -1; return; }
        if (hipFuncSetAttribute((const void*)hybrid_fwd, hipFuncAttributeMaxDynamicSharedMemorySize, LDS_BYTES) != hipSuccess) { fprintf(stderr, "kernel_launch: hipFuncSetAttribute failed\n"); grid = -1; return; }
        if (hipOccupancyMaxActiveBlocksPerMultiprocessor(&per_cu, (const void*)hybrid_fwd, NTHR, LDS_BYTES) != hipSuccess || per_cu < 1) { fprintf(stderr, "kernel_launch: occupancy query says %d\n", per_cu); per_cu = 1; }
        (void)hipGetLastError();
        grid = cus * per_cu;
        if (grid > 256) grid = 256;
    }
    if (grid < 0) return;
    if (hipMemsetAsync((char*)d_ws + WS_CTL, 0, CTL_ZERO_BYTES, stream) != hipSuccess) { fprintf(stderr, "kernel_launch: memset failed\n"); return; }
    Args a{};
    for (int i = 0; i < 25; ++i) a.in[i] = (const float*)d_in[i];
    a.out = (float*)d_out; a.ws = (unsigned char*)d_ws;
#if MK_ONE_LAUNCH
    a.ph_lo = 0; a.ph_hi = NPHASE;
    void* kargs[] = {&a};
    hipError_t e = hipLaunchCooperativeKernel((const void*)hybrid_fwd, dim3(grid), dim3(NTHR), kargs, LDS_BYTES, stream);
    if (e != hipSuccess) fprintf(stderr, "kernel_launch: cooperative launch failed: %s (grid %d)\n", hipGetErrorString(e), grid);
#else
    for (int p = 0; p < NPHASE; ++p) { a.ph_lo = p; a.ph_hi = p + 1; hipLaunchKernelGGL(hybrid_fwd, dim3(grid), dim3(NTHR), LDS_BYTES, stream, a); }
#endif
}
```

```cpp
#include <hip/hip_runtime.h>
#include <hip/hip_cooperative_groups.h>
#include <cstdio>
#include <cstdint>
namespace cg = cooperative_groups;
namespace pg8 {
#define PG8_LAS __attribute__((address_space(3)))
typedef unsigned short bf16_t;
typedef short bf16x8 __attribute__((ext_vector_type(8)));
typedef float f32x4 __attribute__((ext_vector_type(4)));
typedef unsigned u32x4 __attribute__((ext_vector_type(4)));
constexpr int BM = 256, BK = 64, HALF = 128, HTB = HALF * BK * 2  , STAGE_BYTES = 8 * HTB, NXCD = 8, WGM = 2;

__host__ __device__ __forceinline__ int lds_byte(int r, int c) { const int st = (r >> 4) * 2 + (c >> 5), rr = r & 15, cc = c & 31, ob = rr * 64 + cc * 2; return st * 1024 + (ob ^ (((ob >> 9) & 1) << 5)); }
__host__ __device__ __forceinline__ void stage_rc(int b, int& R, int& C) { const int st = b / 1024, sb = b % 1024, swz = sb ^ (((sb >> 9) & 1) << 5); R = (st >> 1) * 16 + swz / 64; C = (st & 1) * 32 + (swz % 64) / 2; }
__host__ __device__ __forceinline__ int perm32(int rho) { const int n = rho >> 4, i = rho & 15; return 8 * (i >> 2) + 4 * n + (i & 3); }

struct Unit { int pm, pn; };
struct Gemm { const bf16_t* A; const bf16_t* Bt; int M, N, K; size_t bstep; int pmb; };

struct StaticOrder {
    int nM, nN, nwg, G, c, wgm;
    __host__ __device__ void init(int M, int N, int G_, int c_, int wgm_ = WGM) { nM = M / BM; nN = N / BM; nwg = nM * nN; G = G_; c = c_; wgm = wgm_; }
    __host__ __device__ bool next(int i, Unit& u) const {
        const long L = (long)i * G + c; if (L >= nwg) return false;
        int wgid = (int)L; { const int q = nwg / NXCD, r = nwg % NXCD, xcd = wgid % NXCD, off = wgid / NXCD; wgid = (xcd < r ? xcd * (q + 1) : r * (q + 1) + (xcd - r) * q) + off; }
        const int nig = wgm * nN, gid = wgid / nig, fm = gid * wgm, gsz = (nM - fm) < wgm ? (nM - fm) : wgm;
        u.pm = fm + ((wgid % nig) % gsz); u.pn = (wgid % nig) / gsz; return true;
    }
    __device__ __forceinline__ void a_ready(const Unit&) const {}
    __device__ __forceinline__ void done(const Unit&) const {}
};

__device__ __forceinline__ unsigned cvt_pk_bf16(float lo, float hi) { unsigned r; asm volatile("v_cvt_pk_bf16_f32 %0, %1, %2" : "=v"(r) : "v"(lo), "v"(hi)); return r; }
template <class Epi, class Sched, bool ALIGN_EPI = false, bool SP2 = false>
__device__ __forceinline__ void gemm_phase(PG8_LAS unsigned char* lds, const Gemm g, const Sched& S, const Epi& E) {
    const int tid = threadIdx.x, wid = __builtin_amdgcn_readfirstlane(tid >> 6), lane = tid & 63, wr = wid >> 2, wc = wid & 3, fr = lane & 15, fq = lane >> 4;
    const int K = g.K, nt = K / BK;
    unsigned voffA[2], voffB[2];
#pragma unroll
    for (int i = 0; i < 2; ++i) { int R, C; stage_rc(tid * 16 + i * 8192, R, C); const int Rb = Epi::PERM ? ((R & ~31) + perm32(R & 31)) : R;
        voffA[i] = (unsigned)(R * K + C) * 2u; voffB[i] = (unsigned)(Rb * K + C) * 2u; }
    const size_t kstep = (size_t)(BK * 2);
    const size_t hstep = (size_t)HALF * K * 2;
    const size_t tstep = 2 * hstep;
    const unsigned ldsw = (unsigned)wid * 1024u;
    const int aoff = lds_byte(wr * 64 + fr, fq * 8), boff = lds_byte(wc * 32 + fr, fq * 8);
#define PG8_SA(b, h) (((b) * 2 + (h)) * HTB)
#define PG8_SB(b, h) ((4 + (b) * 2 + (h)) * HTB)
#define PG8_STAGE(bufoff, gbase, voff) do { _Pragma("unroll") for (int _i = 0; _i < 2; ++_i) \
        __builtin_amdgcn_global_load_lds((const unsigned*)((const char*)(gbase) + (voff)[_i]), (PG8_LAS unsigned*)(lds + (bufoff) + ldsw + _i * 8192), 16, 0, 0); } while (0)
#define PG8_LDA(dst, b, h) do { _Pragma("unroll") for (int m = 0; m < 4; ++m) _Pragma("unroll") for (int k = 0; k < 2; ++k) dst[m][k] = *(const PG8_LAS bf16x8*)(lds + PG8_SA(b, h) + aoff + m * 2048 + k * 1024); } while (0)
#define PG8_LDB(dst, b, h) do { _Pragma("unroll") for (int n = 0; n < 2; ++n) _Pragma("unroll") for (int k = 0; k < 2; ++k) dst[n][k] = *(const PG8_LAS bf16x8*)(lds + PG8_SB(b, h) + boff + n * 2048 + k * 1024); } while (0)
#define PG8_MMA(ai, bj, At, Bt) do { __builtin_amdgcn_s_setprio(1); _Pragma("unroll") for (int m = 0; m < 4; ++m) _Pragma("unroll") for (int n = 0; n < 2; ++n) _Pragma("unroll") for (int k = 0; k < 2; ++k) \
        acc[ai][bj][m][n] = __builtin_amdgcn_mfma_f32_16x16x32_bf16(Bt[n][k], At[m][k], acc[ai][bj][m][n], 0, 0, 0); __builtin_amdgcn_s_setprio(0); } while (0)
#define PG8_WAIT_V(n) asm volatile("s_waitcnt vmcnt(" #n ")" ::: "memory")
#define PG8_WAIT_L(n) asm volatile("s_waitcnt lgkmcnt(" #n ")" ::: "memory")
#define PG8_BAR __builtin_amdgcn_s_barrier()
#define PG8_SCHED __builtin_amdgcn_sched_barrier(0)
    Unit cur, nxt; int ui = 0;
    if (!S.next(0, cur)) return;
    f32x4 acc[2][2][4][2];
#pragma unroll
    for (int a = 0; a < 2; ++a)
#pragma unroll
        for (int b = 0; b < 2; ++b)
#pragma unroll
            for (int m = 0; m < 4; ++m)
#pragma unroll
                for (int n = 0; n < 2; ++n) acc[a][b][m][n] = (f32x4){0.f, 0.f, 0.f, 0.f};
    bf16x8 At[4][2], B0[2][2], B1[2][2];
    const char* cA = (const char*)g.A + (size_t)cur.pm * tstep; const char* cB = (const char*)g.Bt + (size_t)cur.pn * tstep + (size_t)(cur.pm / g.pmb) * g.bstep;
    S.a_ready(cur);
    if constexpr (SP2) {
        PG8_STAGE(PG8_SB(0, 0), cB, voffB); PG8_STAGE(PG8_SB(0, 1), cB + hstep, voffB); PG8_STAGE(PG8_SA(0, 0), cA, voffA); PG8_STAGE(PG8_SA(0, 1), cA + hstep, voffA);
        if (wr == 1) PG8_BAR;
        PG8_WAIT_V(2); PG8_BAR;
        PG8_STAGE(PG8_SB(1, 0), cB + kstep, voffB); PG8_STAGE(PG8_SA(1, 0), cA + kstep, voffA); PG8_STAGE(PG8_SB(1, 1), cB + hstep + kstep, voffB);
        PG8_WAIT_V(6); PG8_BAR;
    } else {
        PG8_STAGE(PG8_SB(0, 0), cB, voffB); PG8_STAGE(PG8_SA(0, 0), cA, voffA); PG8_STAGE(PG8_SB(0, 1), cB + hstep, voffB); PG8_STAGE(PG8_SA(0, 1), cA + hstep, voffA);
        if (wr == 1) PG8_BAR;
        PG8_WAIT_V(4); PG8_BAR;
        PG8_STAGE(PG8_SB(1, 0), cB + kstep, voffB); PG8_STAGE(PG8_SA(1, 0), cA + kstep, voffA); PG8_STAGE(PG8_SB(1, 1), cB + hstep + kstep, voffB);
        PG8_WAIT_V(6); PG8_BAR;
    }
    for (;;) {
        const bool has_next = S.next(ui + 1, nxt);
        const char* nA = has_next ? (const char*)g.A + (size_t)nxt.pm * tstep : cA; const char* nB = has_next ? (const char*)g.Bt + (size_t)nxt.pn * tstep + (size_t)(nxt.pm / g.pmb) * g.bstep : cB;
        for (int t = 0; t < nt; t += 2) {
            const bool last = (t == nt - 2);
            const char* a1 = cA + (size_t)(t + 1) * kstep;
            const char* a2 = last ? nA : cA + (size_t)(t + 2) * kstep; const char* b2 = last ? nB : cB + (size_t)(t + 2) * kstep;
            const char* a3 = a2 + kstep; const char* b3 = b2 + kstep;
            if (last && has_next) S.a_ready(nxt);
            if constexpr (SP2) {
            PG8_LDB(B0, 0, 0); PG8_LDB(B1, 0, 1); PG8_SCHED; PG8_LDA(At, 0, 0); PG8_STAGE(PG8_SA(1, 1), a1 + hstep, voffA);
            PG8_WAIT_V(8); PG8_WAIT_L(0); PG8_BAR; PG8_MMA(0, 0, At, B0); PG8_MMA(0, 1, At, B1); PG8_BAR; PG8_SCHED;
            PG8_LDA(At, 0, 1); PG8_STAGE(PG8_SB(0, 0), b2, voffB); PG8_STAGE(PG8_SB(0, 1), b2 + hstep, voffB); PG8_STAGE(PG8_SA(0, 0), a2, voffA);
            PG8_WAIT_V(8); PG8_WAIT_L(0); PG8_BAR; PG8_MMA(1, 0, At, B0); PG8_MMA(1, 1, At, B1); PG8_BAR; PG8_SCHED;
            PG8_LDB(B0, 1, 0); PG8_LDB(B1, 1, 1); PG8_SCHED; PG8_LDA(At, 1, 0); PG8_STAGE(PG8_SA(0, 1), a2 + hstep, voffA);
            PG8_WAIT_V(8); PG8_WAIT_L(0); PG8_BAR; PG8_MMA(0, 0, At, B0); PG8_MMA(0, 1, At, B1); PG8_BAR; PG8_SCHED;
            PG8_LDA(At, 1, 1); PG8_STAGE(PG8_SB(1, 0), b3, voffB); PG8_STAGE(PG8_SB(1, 1), b3 + hstep, voffB); PG8_STAGE(PG8_SA(1, 0), a3, voffA);
            PG8_WAIT_V(8); PG8_WAIT_L(0); PG8_BAR; PG8_MMA(1, 0, At, B0); PG8_MMA(1, 1, At, B1); PG8_BAR; PG8_SCHED;
            } else {
            PG8_LDB(B0, 0, 0); PG8_SCHED; PG8_LDA(At, 0, 0); PG8_STAGE(PG8_SA(1, 1), a1 + hstep, voffA);
            PG8_WAIT_L(8); PG8_BAR; PG8_WAIT_L(0); PG8_MMA(0, 0, At, B0); PG8_BAR; PG8_SCHED;
            PG8_LDB(B1, 0, 1); PG8_STAGE(PG8_SB(0, 0), b2, voffB);
            PG8_BAR; PG8_WAIT_L(0); PG8_MMA(0, 1, At, B1); PG8_BAR;
            PG8_LDA(At, 0, 1); PG8_STAGE(PG8_SA(0, 0), a2, voffA);
            PG8_BAR; PG8_WAIT_L(0); PG8_MMA(1, 0, At, B0); PG8_BAR; PG8_SCHED;
            PG8_STAGE(PG8_SB(0, 1), b2 + hstep, voffB);
            PG8_WAIT_V(6); PG8_BAR; PG8_MMA(1, 1, At, B1); PG8_BAR;
            PG8_LDB(B0, 1, 0); PG8_SCHED; PG8_LDA(At, 1, 0); PG8_STAGE(PG8_SA(0, 1), a2 + hstep, voffA);
            PG8_WAIT_L(8); PG8_BAR; PG8_WAIT_L(0); PG8_MMA(0, 0, At, B0); PG8_BAR; PG8_SCHED;
            PG8_LDB(B1, 1, 1); PG8_STAGE(PG8_SB(1, 0), b3, voffB);
            PG8_BAR; PG8_WAIT_L(0); PG8_MMA(0, 1, At, B1); PG8_BAR;
            PG8_LDA(At, 1, 1); PG8_STAGE(PG8_SA(1, 0), a3, voffA);
            PG8_BAR; PG8_WAIT_L(0); PG8_MMA(1, 0, At, B0); PG8_BAR; PG8_SCHED;
            PG8_STAGE(PG8_SB(1, 1), b3 + hstep, voffB);
            PG8_WAIT_V(6); PG8_BAR; PG8_MMA(1, 1, At, B1); PG8_BAR;
            }
        }
        if constexpr (ALIGN_EPI) { if (wr == 0) PG8_BAR; }
        if constexpr (!Epi::AFTER_DRAIN) { E(acc, cur, wr, wc, fr, fq); S.done(cur); }
        if (!has_next) break;
#pragma unroll
        for (int a = 0; a < 2; ++a)
#pragma unroll
            for (int b = 0; b < 2; ++b)
#pragma unroll
                for (int m = 0; m < 4; ++m)
#pragma unroll
                    for (int n = 0; n < 2; ++n) acc[a][b][m][n] = (f32x4){0.f, 0.f, 0.f, 0.f};
        cur = nxt; cA = nA; cB = nB; ++ui;
        if constexpr (ALIGN_EPI) { if (wr == 1) PG8_BAR; }
    }
    PG8_WAIT_V(0);
    if constexpr (!ALIGN_EPI) { if (wr == 0) PG8_BAR; }
    PG8_BAR;
    if constexpr (Epi::AFTER_DRAIN) { E.fused(acc, cur, wr, wc, fr, fq, lds, wid, lane); S.done(cur); }
#undef PG8_SA
#undef PG8_SB
#undef PG8_STAGE
#undef PG8_LDA
#undef PG8_LDB
#undef PG8_MMA
#undef PG8_WAIT_V
#undef PG8_WAIT_L
#undef PG8_BAR
#undef PG8_SCHED
}
typedef __bf16 bf16x2_t __attribute__((ext_vector_type(2))); typedef float f32x2 __attribute__((ext_vector_type(2)));
__device__ __forceinline__ unsigned pk2(float lo, float hi) { f32x2 v = {lo, hi}; bf16x2_t b = __builtin_convertvector(v, bf16x2_t); return __builtin_bit_cast(unsigned, b); }
__device__ __forceinline__ float silu_f(float v) { return v * __builtin_amdgcn_rcpf(1.0f + __expf(-v)); }
template <bool FUSED> struct EpiSwiGLU {
    static constexpr bool PERM = true, AFTER_DRAIN = false;
    bf16_t* O; const float* rssq; const float* sW; int ldc; int sw_bstride; int rows_per_batch;
    __device__ __forceinline__ void operator()(const f32x4 (&acc)[2][2][4][2], const Unit& u, int wr, int wc, int fr, int fq) const {
        const int row0 = u.pm * BM + wr * 64 + fr, col0 = u.pn * HALF + wc * 32 + 8 * fq;
        f32x4 sg[2], su[2];
        if (FUSED) { const float* sp = sW + (size_t)((u.pm * BM) / rows_per_batch) * sw_bstride + u.pn * BM + wc * 32 + 8 * fq;
            sg[0] = *(const f32x4*)sp; sg[1] = *(const f32x4*)(sp + 4); su[0] = *(const f32x4*)(sp + HALF); su[1] = *(const f32x4*)(sp + HALF + 4); }
#pragma unroll
        for (int ai = 0; ai < 2; ++ai)
#pragma unroll
            for (int m = 0; m < 4; ++m) { bf16_t* rowp = O + (size_t)(row0 + ai * HALF + m * 16) * ldc + col0;
                f32x4 g0 = acc[ai][0][m][0], g1 = acc[ai][0][m][1], u0 = acc[ai][1][m][0], u1 = acc[ai][1][m][1];
                if (FUSED) { const float rs = rsqrtf(rssq[row0 + ai * HALF + m * 16] * (1.f / 1024.f) + 1e-6f); g0 = g0 * rs + sg[0]; g1 = g1 * rs + sg[1]; u0 = u0 * rs + su[0]; u1 = u1 * rs + su[1]; }
                u32x4 w; w.x = pk2(silu_f(g0[0]) * u0[0], silu_f(g0[1]) * u0[1]); w.y = pk2(silu_f(g0[2]) * u0[2], silu_f(g0[3]) * u0[3]);
                w.z = pk2(silu_f(g1[0]) * u1[0], silu_f(g1[1]) * u1[1]); w.w = pk2(silu_f(g1[2]) * u1[2], silu_f(g1[3]) * u1[3]);
                *(u32x4*)rowp = w; }
    }
};
template <bool BASE_BF16, bool OUT_BF16, bool RS = false, bool SSQ = false> struct EpiResid {
    static constexpr bool PERM = true, AFTER_DRAIN = false;
    const void* base; void* out; const float* gate; const float* rssq; float* ossq; int ldc; int gate_bstride; int rows_per_batch; float coef; float rs_inv_n;
    __device__ __forceinline__ void operator()(const f32x4 (&acc)[2][2][4][2], const Unit& u, int wr, int wc, int fr, int fq) const {
        const int row0 = u.pm * BM + wr * 64 + fr, col0 = u.pn * BM + wc * 32 + 8 * fq;
        const float* gp = gate + (size_t)((u.pm * BM) / rows_per_batch) * gate_bstride + col0;
        f32x4 gv[2][2];
#pragma unroll
        for (int bj = 0; bj < 2; ++bj)
#pragma unroll
            for (int n = 0; n < 2; ++n) gv[bj][n] = (*(const f32x4*)(gp + bj * HALF + n * 4) + 1.0f) * coef;
        constexpr int GB = BASE_BF16 ? 4 : 2;
#pragma unroll
        for (int gb = 0; gb < 8; gb += GB) {
            u32x4 braw[GB][2][BASE_BF16 ? 1 : 2];
#pragma unroll
            for (int q = 0; q < GB; ++q) { const int ai = (gb + q) >> 2, m = (gb + q) & 3; const size_t off = (size_t)(row0 + ai * HALF + m * 16) * ldc + col0;
#pragma unroll
                for (int bj = 0; bj < 2; ++bj) {
                    if (BASE_BF16) braw[q][bj][0] = *(const u32x4*)((const bf16_t*)base + off + bj * HALF);
                    else { braw[q][bj][0] = *(const u32x4*)((const float*)base + off + bj * HALF); braw[q][bj][BASE_BF16 ? 0 : 1] = *(const u32x4*)((const float*)base + off + bj * HALF + 4); } } }
#pragma unroll
            for (int q = 0; q < GB; ++q) { const int ai = (gb + q) >> 2, m = (gb + q) & 3; const size_t off = (size_t)(row0 + ai * HALF + m * 16) * ldc + col0;
                float rsc = 1.0f; if (RS) rsc = rsqrtf(rssq[row0 + ai * HALF + m * 16] * rs_inv_n + 1e-6f);
                float sq = 0.f;
#pragma unroll
                for (int bj = 0; bj < 2; ++bj) {
                    f32x4 b0, b1;
                    if (BASE_BF16) { const u32x4 w = braw[q][bj][0];
                        b0 = (f32x4){__uint_as_float(w.x << 16), __uint_as_float(w.x & 0xffff0000u), __uint_as_float(w.y << 16), __uint_as_float(w.y & 0xffff0000u)};
                        b1 = (f32x4){__uint_as_float(w.z << 16), __uint_as_float(w.z & 0xffff0000u), __uint_as_float(w.w << 16), __uint_as_float(w.w & 0xffff0000u)}; }
                    else { b0 = __builtin_bit_cast(f32x4, braw[q][bj][0]); b1 = __builtin_bit_cast(f32x4, braw[q][bj][BASE_BF16 ? 0 : 1]); }
                    f32x4 a0 = acc[ai][bj][m][0], a1 = acc[ai][bj][m][1]; if (RS) { a0 = a0 * rsc; a1 = a1 * rsc; }
                    const f32x4 o0 = b0 + a0 * gv[bj][0], o1 = b1 + a1 * gv[bj][1];
                    if (SSQ) sq += (o0[0] * o0[0] + o0[1] * o0[1]) + (o0[2] * o0[2] + o0[3] * o0[3]) + (o1[0] * o1[0] + o1[1] * o1[1]) + (o1[2] * o1[2] + o1[3] * o1[3]);
                    if (OUT_BF16) { u32x4 w; w.x = pk2(o0[0], o0[1]); w.y = pk2(o0[2], o0[3]); w.z = pk2(o1[0], o1[1]); w.w = pk2(o1[2], o1[3]); *(u32x4*)((bf16_t*)out + off + bj * HALF) = w; }
                    else { *(f32x4*)((float*)out + off + bj * HALF) = o0; *(f32x4*)((float*)out + off + bj * HALF + 4) = o1; }
                }
                if (SSQ) { sq += __shfl_xor(sq, 16); sq += __shfl_xor(sq, 32); if (fq == 0) __hip_atomic_fetch_add(ossq + row0 + ai * HALF + m * 16, sq, __ATOMIC_RELAXED, __HIP_MEMORY_SCOPE_AGENT); }
            }
            asm volatile("" ::: "memory");
        }
    }
};
struct EpiProj {
    static constexpr bool PERM = true, AFTER_DRAIN = false;
    bf16_t* O; float* DT; const float* dt_bias; const float* rssq; const float* sW; int ldc; int nfull; int sw_bstride; int rows_per_batch;
    __device__ __forceinline__ void operator()(const f32x4 (&acc)[2][2][4][2], const Unit& u, int wr, int wc, int fr, int fq) const {
        const int row0 = u.pm * BM + wr * 64 + fr;
        const float* sp = sW + (size_t)((u.pm * BM) / rows_per_batch) * sw_bstride + u.pn * BM + wc * 32 + 8 * fq;
        if (u.pn < nfull) {
            const int col0 = u.pn * BM + wc * 32 + 8 * fq;
            f32x4 sv[2][2];
#pragma unroll
            for (int bj = 0; bj < 2; ++bj) { sv[bj][0] = *(const f32x4*)(sp + bj * HALF); sv[bj][1] = *(const f32x4*)(sp + bj * HALF + 4); }
#pragma unroll
            for (int ai = 0; ai < 2; ++ai)
#pragma unroll
                for (int m = 0; m < 4; ++m) { bf16_t* rowp = O + (size_t)(row0 + ai * HALF + m * 16) * ldc + col0;
                    const float rs = rsqrtf(rssq[row0 + ai * HALF + m * 16] * (1.f / 1024.f) + 1e-6f);
#pragma unroll
                    for (int bj = 0; bj < 2; ++bj) { const f32x4 v0 = acc[ai][bj][m][0] * rs + sv[bj][0], v1 = acc[ai][bj][m][1] * rs + sv[bj][1];
                        u32x4 w; w.x = pk2(v0[0], v0[1]); w.y = pk2(v0[2], v0[3]); w.z = pk2(v1[0], v1[1]); w.w = pk2(v1[2], v1[3]);
                        *(u32x4*)(rowp + bj * HALF) = w; } }
        } else if (wc == 0 && fq < 2) {
            const f32x4 b0 = *(const f32x4*)(dt_bias + 8 * fq) + *(const f32x4*)sp, b1 = *(const f32x4*)(dt_bias + 8 * fq + 4) + *(const f32x4*)(sp + 4);
#pragma unroll
            for (int ai = 0; ai < 2; ++ai)
#pragma unroll
                for (int m = 0; m < 4; ++m) { float* rowp = DT + (size_t)(row0 + ai * HALF + m * 16) * 16 + 8 * fq;
                    const float rs = rsqrtf(rssq[row0 + ai * HALF + m * 16] * (1.f / 1024.f) + 1e-6f);
                    f32x4 v0 = acc[ai][0][m][0] * rs + b0, v1 = acc[ai][0][m][1] * rs + b1;
#pragma unroll
                    for (int j = 0; j < 4; ++j) { v0[j] = v0[j] > 20.f ? v0[j] : log1pf(__expf(v0[j])); v1[j] = v1[j] > 20.f ? v1[j] : log1pf(__expf(v1[j])); }
                    *(f32x4*)rowp = v0; *(f32x4*)(rowp + 4) = v1; }
        }
    }
};
struct EpiNull { static constexpr bool PERM = true, AFTER_DRAIN = false; float* sink;
    __device__ __forceinline__ void operator()(const f32x4 (&acc)[2][2][4][2], const Unit& u, int wr, int wc, int fr, int fq) const {
        f32x4 s = {0.f, 0.f, 0.f, 0.f};
#pragma unroll
        for (int ai = 0; ai < 2; ++ai)
#pragma unroll
            for (int bj = 0; bj < 2; ++bj)
#pragma unroll
                for (int m = 0; m < 4; ++m)
#pragma unroll
                    for (int n = 0; n < 2; ++n) s += acc[ai][bj][m][n];
        if (s[0] + s[1] + s[2] + s[3] == 123.456f) sink[0] = s[0]; }
};
}
#define GAS __attribute__((address_space(1)))
#define LAS __attribute__((address_space(3)))
typedef unsigned short bf16;
typedef unsigned v4u __attribute__((ext_vector_type(4)));
typedef unsigned v2u __attribute__((ext_vector_type(2)));
typedef float f32x4 __attribute__((ext_vector_type(4)));
typedef float f32x16 __attribute__((ext_vector_type(16)));
typedef short bf16x8 __attribute__((ext_vector_type(8)));
typedef short s16x4 __attribute__((ext_vector_type(4)));
typedef short v4i16_t __attribute__((ext_vector_type(4)));
using pg8::pk2; using pg8::silu_f;

constexpr int NWAVES = 8, NTHR = 512;
constexpr int D = 1024, BATCH = 4, SEQ = 8192, M = BATCH * SEQ;
constexpr int DFF = 2816, NGU = 2 * DFF;
constexpr int NPROJ = 2304, NPROJ_PAD = 2560, IN_WIDTH = 2320;
constexpr int PZ = 0, PXBC = 512, PQ = 1536, PK = 2048, PV = 2176;
constexpr int NCHUNK = 64, CH = 128;
constexpr int NMOD = 9 * D;
constexpr float EPS = 1e-6f;
constexpr float LOG2E = 1.4426950408889634f;
constexpr float QSCALE = 0.125f * LOG2E;

constexpr size_t MiB = 1u << 20;
constexpr size_t WS_CTL = 0, CTL_ZERO_BYTES = 1 * MiB;
constexpr size_t CTL_MOD = 65536, CTL_BAR = 16384, CTL_SSQ = 262144, CTL_RSSQ1 = 393216, CTL_RSSQ2 = 524288, CTL_SW2 = 655360, CTL_SW3 = 720896;
constexpr size_t WS_WGU1 = 2 * MiB, WS_WD1 = 13 * MiB, WS_WIN = 19 * MiB, WS_WOUT = 24 * MiB, WS_WGU2 = 26 * MiB, WS_WD2 = 37 * MiB;
constexpr size_t WS_DT = 43 * MiB, WS_CD = 45 * MiB;
constexpr size_t WS_U = 48 * MiB;
constexpr size_t WS_H = 112 * MiB;
constexpr size_t WS_WINB = 288 * MiB;
constexpr size_t WS_WGU2B = 308 * MiB;
constexpr size_t WS_X1 = 416 * MiB;
constexpr size_t WS_END = 480 * MiB;

constexpr int XS_PITCH = 528, BS_PITCH = 272, KV_PITCH = 144;
constexpr int L_XS = 0, L_BS = 128 * XS_PITCH, L_CS = L_BS + 128 * BS_PITCH, L_ARR = L_CS + 128 * BS_PITCH, L_END = L_ARR + 8192;
constexpr int LDS_BYTES = 152 * 1024;
static_assert(L_END + 64 <= LDS_BYTES && pg8::STAGE_BYTES <= LDS_BYTES, "LDS map");

struct Frame { LAS unsigned char* lds; int tid, lane, wave, vcu, G; };

__device__ __forceinline__ float bf_lo(unsigned w) { return __uint_as_float(w << 16); }
__device__ __forceinline__ float bf_hi(unsigned w) { return __uint_as_float(w & 0xffff0000u); }
__device__ __forceinline__ float wave_sum(float v) {
#pragma unroll
    for (int o = 1; o < 64; o <<= 1) v += __shfl_xor(v, o);
    return v;
}
#define LDS_WAIT() asm volatile("s_waitcnt lgkmcnt(0)" ::: "memory")
__device__ __forceinline__ f32x16 mfma32(bf16x8 a, bf16x8 b, f32x16 c) { return __builtin_amdgcn_mfma_f32_32x32x16_bf16(a, b, c, 0, 0, 0); }
__device__ __forceinline__ int crow(int reg, int h) { return (reg & 3) + 8 * (reg >> 2) + 4 * h; }
__device__ __forceinline__ bf16x8 frag_row(const LAS unsigned char* base, int pitch, int mn0, int k0, int lane) {
    return *(const LAS bf16x8*)(base + (mn0 + (lane & 31)) * pitch + (k0 + 8 * (lane >> 5)) * 2);
}
__device__ __forceinline__ s16x4 ds_tr(const LAS unsigned char* p) { return __builtin_bit_cast(s16x4, __builtin_amdgcn_ds_read_tr16_b64_v4i16((LAS v4i16_t*)p)); }
__device__ __forceinline__ bf16x8 frag_tr(const LAS unsigned char* base, int pitch, int kA, int kB, int mn0, int lane) {
    const int q4 = (lane & 15) >> 2, cb = (mn0 + 16 * ((lane >> 4) & 1) + 4 * (lane & 3)) * 2;
    const s16x4 a = ds_tr(base + (kA + q4) * pitch + cb), b = ds_tr(base + (kB + q4) * pitch + cb);
    bf16x8 r; r[0] = a[0]; r[1] = a[1]; r[2] = a[2]; r[3] = a[3]; r[4] = b[0]; r[5] = b[1]; r[6] = b[2]; r[7] = b[3]; return r;
}
__device__ __forceinline__ int perm_row(int m, int t) { return 32 * ((m >> 2) & 1) + 16 * t + 4 * (m >> 3) + (m & 3); }
__device__ __forceinline__ bf16x8 frag_tr_perm(const LAS unsigned char* base, int pitch, int kA, int kB, int mn_base, int t, int lane) {
    const int q4 = (lane & 15) >> 2, cb = (mn_base + 32 * (lane & 1) + 16 * t + 8 * ((lane >> 4) & 1) + 4 * ((lane >> 1) & 1)) * 2;
    const s16x4 a = ds_tr(base + (kA + q4) * pitch + cb), b2 = ds_tr(base + (kB + q4) * pitch + cb);
    bf16x8 r; r[0] = a[0]; r[1] = a[1]; r[2] = a[2]; r[3] = a[3]; r[4] = b2[0]; r[5] = b2[1]; r[6] = b2[2]; r[7] = b2[3]; return r;
}
__device__ __forceinline__ bf16x8 pack_step(const f32x16& x, int s) {
    v4u p; p.x = pk2(x[8 * s], x[8 * s + 1]); p.y = pk2(x[8 * s + 2], x[8 * s + 3]); p.z = pk2(x[8 * s + 4], x[8 * s + 5]); p.w = pk2(x[8 * s + 6], x[8 * s + 7]);
    return __builtin_bit_cast(bf16x8, p);
}

template <int MAP> __device__ __forceinline__ int map_row(int n) {
    if (MAP == 1) return 256 * (n >> 7) + (n & 127);
    if (MAP == 2) return 256 * (n >> 7) + 128 + (n & 127);
    if (MAP == 3) { if (n < 1536) return n; if (n < 1552) return NPROJ + (n - 1536); return n - 16; }
    return n;
}
template <int MAP>
__device__ __forceinline__ void transpose_item(const float* W, int K, int N, bf16* WT, LAS float* scr, int item, int lane) {
    const int nblk = (N + 31) / 32, kb = item / nblk, nb = item % nblk, k0 = 64 * kb, n0 = 32 * nb;
    const int nn = n0 + (lane & 31);
#pragma unroll
    for (int i = 0; i < 32; ++i) { const int kk = 2 * i + (lane >> 5); scr[kk * 33 + (lane & 31)] = nn < N ? W[(size_t)(k0 + kk) * N + nn] : 0.f; }
    LDS_WAIT(); asm volatile("" ::: "memory");
    const int c = lane & 7;
#pragma unroll
    for (int j = 0; j < 4; ++j) { const int n = (lane >> 3) + 8 * j; const LAS float* s = scr + (8 * c) * 33 + n;
        v4u o; o.x = pk2(s[0 * 33], s[1 * 33]); o.y = pk2(s[2 * 33], s[3 * 33]); o.z = pk2(s[4 * 33], s[5 * 33]); o.w = pk2(s[6 * 33], s[7 * 33]);
        if (n0 + n < N) *(v4u*)(WT + (size_t)map_row<MAP>(n0 + n) * K + k0 + 8 * c) = o; }
    LDS_WAIT(); asm volatile("" ::: "memory");
}
struct P0Args { const float *wg1, *wu1, *wd1, *wout, *wd2, *c, *wada, *bada; bf16 *WGU1, *WD1, *WOUT, *WD2; float* mod; };
__device__ __forceinline__ void p0_prologue(const Frame& F, const P0Args& A) {
    LAS float* scr = (LAS float*)(F.lds + F.wave * 16384);
    const int gw = F.vcu * NWAVES + F.wave, NGW = F.G * NWAVES;
    constexpr int I_GU = (D / 64) * (DFF / 32), I_D = (DFF / 64) * (D / 32), I_O = (D / 64) * (D / 32);
    constexpr int NITEMS = 2 * I_GU + 2 * I_D + I_O;
    for (int it = gw; it < NITEMS; it += NGW) {
        int r = it;
        if (r < I_GU) { transpose_item<1>(A.wg1, D, DFF, A.WGU1, scr, r, F.lane); continue; } r -= I_GU;
        if (r < I_GU) { transpose_item<2>(A.wu1, D, DFF, A.WGU1, scr, r, F.lane); continue; } r -= I_GU;
        if (r < I_D)  { transpose_item<0>(A.wd1, DFF, D, A.WD1, scr, r, F.lane); continue; } r -= I_D;
        if (r < I_D)  { transpose_item<0>(A.wd2, DFF, D, A.WD2, scr, r, F.lane); continue; } r -= I_D;
        transpose_item<0>(A.wout, D, D, A.WOUT, scr, r, F.lane);
    }
    constexpr int NCG = NMOD / 64, NKS = D / 64;
    for (int it = gw; it < NCG * NKS; it += NGW) {
        const int cgp = it % NCG, ks = it / NCG, n = cgp * 64 + F.lane, k0 = ks * 64;
        float s[4], acc[4] = {0.f, 0.f, 0.f, 0.f};
#pragma unroll
        for (int b = 0; b < 4; ++b) s[b] = silu_f(A.c[b * D + k0 + F.lane]);
        const float* wp = A.wada + (size_t)k0 * NMOD + n;
#pragma unroll 32
        for (int kk = 0; kk < 64; ++kk) { const float w = wp[(size_t)kk * NMOD];
#pragma unroll
            for (int b = 0; b < 4; ++b) acc[b] += w * __uint_as_float(__builtin_amdgcn_readlane(__float_as_uint(s[b]), kk)); }
        const float bias = ks == 0 ? A.bada[n] : 0.f;
#pragma unroll
        for (int b = 0; b < 4; ++b) __hip_atomic_fetch_add(A.mod + b * NMOD + n, acc[b] + bias, __ATOMIC_RELAXED, __HIP_MEMORY_SCOPE_AGENT);
    }
}

template <int MAP>
__device__ __forceinline__ void scale_item(const float* W, int K, int N, bf16* WB, size_t copy_stride, const float* gain, const float* mod, int i_shift, int i_scale, float* sW, int sw_stride, LAS float* scr, int item, int lane) {
    const int nblk = (N + 31) / 32, kb = item / nblk, nb = item % nblk, k0 = 64 * kb, n0 = 32 * nb;
    const int nn = n0 + (lane & 31);
#pragma unroll
    for (int i = 0; i < 32; ++i) { const int kk = 2 * i + (lane >> 5); scr[kk * 33 + (lane & 31)] = nn < N ? W[(size_t)(k0 + kk) * N + nn] : 0.f; }
    float gsv[4], shv[4];
    { const float gn = gain[k0 + lane];
#pragma unroll
      for (int b = 0; b < 4; ++b) { gsv[b] = gn * (1.0f + mod[b * NMOD + i_scale * D + k0 + lane]); shv[b] = mod[b * NMOD + i_shift * D + k0 + lane]; } }
    LDS_WAIT(); asm volatile("" ::: "memory");
    { float acc[4] = {0.f, 0.f, 0.f, 0.f};
#pragma unroll 16
      for (int kk = 0; kk < 64; ++kk) { const float w = scr[kk * 33 + (lane & 31)];
#pragma unroll
          for (int b = 0; b < 4; ++b) acc[b] += w * __uint_as_float(__builtin_amdgcn_readlane(__float_as_uint(shv[b]), kk)); }
      if (lane < 32 && nn < N) {
#pragma unroll
          for (int b = 0; b < 4; ++b) __hip_atomic_fetch_add(sW + b * sw_stride + map_row<MAP>(nn), acc[b], __ATOMIC_RELAXED, __HIP_MEMORY_SCOPE_AGENT); } }
    const int c = lane & 7;
#pragma unroll
    for (int b = 0; b < 4; ++b) {
        float gk[8];
#pragma unroll
        for (int jj = 0; jj < 8; ++jj) gk[jj] = __shfl(gsv[b], 8 * c + jj);
#pragma unroll
        for (int j = 0; j < 4; ++j) { const int n = (lane >> 3) + 8 * j; const LAS float* s = scr + (8 * c) * 33 + n;
            v4u o; o.x = pk2(s[0 * 33] * gk[0], s[1 * 33] * gk[1]); o.y = pk2(s[2 * 33] * gk[2], s[3 * 33] * gk[3]); o.z = pk2(s[4 * 33] * gk[4], s[5 * 33] * gk[5]); o.w = pk2(s[6 * 33] * gk[6], s[7 * 33] * gk[7]);
            if (n0 + n < N) *(v4u*)(WB + b * copy_stride + (size_t)map_row<MAP>(n0 + n) * K + k0 + 8 * c) = o; }
    }
    LDS_WAIT(); asm volatile("" ::: "memory");
}
struct PrepArgs { const float *win, *wg2, *wu2, *gain2, *gain3, *mod; bf16 *WINB, *WGU2B; float *sW2, *sW3; };
constexpr int PREP_I_GU = (D / 64) * (DFF / 32), PREP_I_IN = (D / 64) * ((IN_WIDTH + 31) / 32), PREP_ITEMS = 2 * PREP_I_GU + PREP_I_IN;
__device__ __forceinline__ void prep_one(const Frame& F, const PrepArgs& A, int k) {
    LAS float* scr = (LAS float*)(F.lds + F.wave * 16384);
    int r = F.vcu + F.G * k;
    if (r >= PREP_ITEMS) return;
    if (r < PREP_I_IN) { scale_item<3>(A.win, D, IN_WIDTH, A.WINB, (size_t)NPROJ_PAD * D, A.gain2, A.mod, 3, 4, A.sW2, NPROJ_PAD, scr, r, F.lane); return; } r -= PREP_I_IN;
    if (r < PREP_I_GU) { scale_item<1>(A.wg2, D, DFF, A.WGU2B, (size_t)NGU * D, A.gain3, A.mod, 6, 7, A.sW3, NGU, scr, r, F.lane); return; } r -= PREP_I_GU;
    scale_item<2>(A.wu2, D, DFF, A.WGU2B, (size_t)NGU * D, A.gain3, A.mod, 6, 7, A.sW3, NGU, scr, r, F.lane);
}
__device__ __forceinline__ void prep_phase(const Frame& F, const PrepArgs& A, bool do_items) {
    LAS float* scr = (LAS float*)(F.lds + F.wave * 16384);
    const int gw = F.vcu * NWAVES + F.wave, NGW = F.G * NWAVES;
    constexpr int I_GU = (D / 64) * (DFF / 32), I_IN = (D / 64) * ((IN_WIDTH + 31) / 32);
    for (int it = gw; do_items && it < 2 * I_GU + I_IN; it += NGW) {
        int r = it;
        if (r < I_IN) { scale_item<3>(A.win, D, IN_WIDTH, A.WINB, (size_t)NPROJ_PAD * D, A.gain2, A.mod, 3, 4, A.sW2, NPROJ_PAD, scr, r, F.lane); continue; } r -= I_IN;
        if (r < I_GU) { scale_item<1>(A.wg2, D, DFF, A.WGU2B, (size_t)NGU * D, A.gain3, A.mod, 6, 7, A.sW3, NGU, scr, r, F.lane); continue; } r -= I_GU;
        scale_item<2>(A.wu2, D, DFF, A.WGU2B, (size_t)NGU * D, A.gain3, A.mod, 6, 7, A.sW3, NGU, scr, r, F.lane);
    }
    { const int gt = (F.vcu * NTHR + F.tid), NT = F.G * NTHR; v4u z = {0u, 0u, 0u, 0u}; constexpr int PER = (NPROJ_PAD - IN_WIDTH) * D / 8;
      for (int i = gt; i < 4 * PER; i += NT) { const int b = i / PER, j = i % PER; *(v4u*)(A.WINB + (size_t)b * NPROJ_PAD * D + (size_t)IN_WIDTH * D + (size_t)j * 8) = z; } }
}

template <bool IN_BF16>
__device__ __forceinline__ void norm_phase(const Frame& F, const void* xin_, const float* gain, const float* mod, int i_shift, int i_scale, bf16* U) {
    const int gw = F.vcu * NWAVES + F.wave, NGW = F.G * NWAVES;
    for (int m0 = gw * 16; m0 < M; m0 += NGW * 16) {
        const int b = m0 / SEQ;
        f32x4 gs[4], sh[4];
#pragma unroll
        for (int j = 0; j < 4; ++j) { const int col = 4 * F.lane + 256 * j;
            const f32x4 g = *(const f32x4*)(gain + col), sc = *(const f32x4*)(mod + b * NMOD + i_scale * D + col);
            gs[j] = g * (sc + 1.0f); sh[j] = *(const f32x4*)(mod + b * NMOD + i_shift * D + col); }
        for (int r = 0; r < 16; ++r) {
            f32x4 v[4]; float s = 0.f;
            if (IN_BF16) { const v2u* xr = (const v2u*)((const bf16*)xin_ + (size_t)(m0 + r) * D) + F.lane;
#pragma unroll
                for (int j = 0; j < 4; ++j) { const v2u w = xr[64 * j]; v[j] = (f32x4){bf_lo(w.x), bf_hi(w.x), bf_lo(w.y), bf_hi(w.y)}; } }
            else { const f32x4* xr = (const f32x4*)((const float*)xin_ + (size_t)(m0 + r) * D) + F.lane;
#pragma unroll
                for (int j = 0; j < 4; ++j) v[j] = xr[64 * j]; }
#pragma unroll
            for (int j = 0; j < 4; ++j) s += (v[j].x * v[j].x + v[j].y * v[j].y) + (v[j].z * v[j].z + v[j].w * v[j].w);
            const float rstd = rsqrtf(wave_sum(s) * (1.f / D) + EPS);
            v2u* o8 = (v2u*)(U + (size_t)(m0 + r) * D) + F.lane;
#pragma unroll
            for (int j = 0; j < 4; ++j) { const f32x4 o = v[j] * rstd * gs[j] + sh[j]; v2u w; w.x = pk2(o.x, o.y); w.y = pk2(o.z, o.w); o8[64 * j] = w; }
        }
    }
}
typedef GAS unsigned gu32;
#define RLX_AGENT __ATOMIC_RELAXED, __HIP_MEMORY_SCOPE_AGENT
#define XB_TMO      128
#define XB_XCNT(j)  (256  + 64 * (j))
#define XB_XSUB(j)  (1280 + 64 * (j))
#define XB_XGEN(j)  (2304 + 64 * (j))
#define XB_TOP      3328
#define XB_TOPGEN   3392
#define XCD_BAR_WORDS 3456
#define XB_SPIN_CAP (1u << 18)

__device__ __forceinline__ unsigned xb_ld(unsigned* p)              { return __hip_atomic_load(p, __ATOMIC_RELAXED, __HIP_MEMORY_SCOPE_AGENT); }
__device__ __forceinline__ unsigned xb_add(unsigned* p, unsigned v) { return __hip_atomic_fetch_add(p, v, __ATOMIC_RELAXED, __HIP_MEMORY_SCOPE_AGENT); }
__device__ __forceinline__ unsigned xb_xcc_id() { return (unsigned)__builtin_amdgcn_s_getreg((3 << 11) | 20) & 0xFu; }
#define XB_SPIN(cond, bar) do { unsigned _sp = 0; while (cond) { __builtin_amdgcn_s_sleep(1); \
    if ((++_sp & 255u) == 0u) { if (xb_ld(&(bar)[XB_TMO])) break; if (_sp > XB_SPIN_CAP) { atomicAdd(&(bar)[XB_TMO], 1u); break; } } } } while (0)

struct XcdBarrier {
    unsigned* bar; unsigned x;
    volatile LAS unsigned* st;
};

__device__ __forceinline__ XcdBarrier xcd_barrier_post(unsigned* bar, volatile LAS unsigned* st) {
    XcdBarrier b; b.bar = bar; b.x = xb_xcc_id(); b.st = st;
    if (threadIdx.x == 0) (void)xb_add(&bar[XB_XCNT(b.x)], 1u);
    return b;
}
__device__ __forceinline__ void xcd_barrier_complete(unsigned* bar, unsigned x, unsigned& nloc, unsigned& nx) {
    const unsigned G = gridDim.x * gridDim.y * gridDim.z;
    unsigned sum, cnt, mine, sp = 0u;
    for (;;) {
        sum = 0u; cnt = 0u; mine = 0u;
#pragma unroll
        for (unsigned j = 0; j < 16; ++j) { const unsigned c = xb_ld(&bar[XB_XCNT(j)]); sum += c; cnt += (c > 0u) ? 1u : 0u; mine = (j == x) ? c : mine; }
        if (sum == G) break;
        __builtin_amdgcn_s_sleep(1);
        if ((++sp & 255u) == 0u) { if (xb_ld(&bar[XB_TMO])) break; if (sp > XB_SPIN_CAP) { atomicAdd(&bar[XB_TMO], 1u); break; } }
    }
    nloc = mine > 0u ? mine : 1u; nx = cnt > 0u ? cnt : 1u;
}

__device__ __forceinline__ void xcd_barrier(const XcdBarrier& b) {
    asm volatile("s_waitcnt vmcnt(0)" ::: "memory");
    __syncthreads();
    if (threadIdx.x == 0) {
        unsigned* bar = b.bar;
        __builtin_amdgcn_s_waitcnt(0);
        unsigned nloc = b.st[0], nx = b.st[1];
        if (nloc == 0u) { xcd_barrier_complete(bar, b.x, nloc, nx); b.st[0] = nloc; b.st[1] = nx; }
        const unsigned old = xb_add(&bar[XB_XSUB(b.x)], 1u);
        const unsigned gen = old / nloc;
        if (old + 1u == (gen + 1u) * nloc) {
            __builtin_amdgcn_fence(__ATOMIC_RELEASE, "agent");
            asm volatile("s_waitcnt vmcnt(0)" ::: "memory");
            const unsigned og = xb_add(&bar[XB_TOP], 1u);
            const unsigned tg = og / nx;
            if (og + 1u == (tg + 1u) * nx) xb_add(&bar[XB_TOPGEN], 1u);
            else XB_SPIN(xb_ld(&bar[XB_TOPGEN]) == tg, bar);
            __builtin_amdgcn_fence(__ATOMIC_ACQUIRE, "agent");
            xb_add(&bar[XB_XGEN(b.x)], 1u);
            asm volatile("s_waitcnt vmcnt(0)" ::: "memory");
        } else {
            XB_SPIN(xb_ld(&bar[XB_XGEN(b.x)]) == gen, bar);
            __builtin_amdgcn_fence(__ATOMIC_ACQUIRE, "agent");
            asm volatile("s_waitcnt vmcnt(0)" ::: "memory");
        }
    }
    __syncthreads();
}

template <class WorkT>
__device__ __forceinline__ void xcd_barrier_w(const XcdBarrier& b, const WorkT& work) {
    asm volatile("s_waitcnt vmcnt(0)" ::: "memory");
    __syncthreads();
    if (threadIdx.x == 0) {
        unsigned* bar = b.bar;
        __builtin_amdgcn_s_waitcnt(0);
        unsigned nloc = b.st[0], nx = b.st[1];
        if (nloc == 0u) { xcd_barrier_complete(bar, b.x, nloc, nx); b.st[0] = nloc; b.st[1] = nx; }
        const unsigned old = xb_add(&bar[XB_XSUB(b.x)], 1u);
        const unsigned gen = old / nloc;
        if (old + 1u == (gen + 1u) * nloc) {
            __builtin_amdgcn_fence(__ATOMIC_RELEASE, "agent");
            asm volatile("s_waitcnt vmcnt(0)" ::: "memory");
            const unsigned og = xb_add(&bar[XB_TOP], 1u);
            const unsigned tg = og / nx;
            if (og + 1u == (tg + 1u) * nx) xb_add(&bar[XB_TOPGEN], 1u);
            else XB_SPIN(xb_ld(&bar[XB_TOPGEN]) == tg, bar);
            __builtin_amdgcn_fence(__ATOMIC_ACQUIRE, "agent");
            xb_add(&bar[XB_XGEN(b.x)], 1u);
            asm volatile("s_waitcnt vmcnt(0)" ::: "memory");
        } else {
            XB_SPIN(xb_ld(&bar[XB_XGEN(b.x)]) == gen, bar);
            __builtin_amdgcn_fence(__ATOMIC_ACQUIRE, "agent");
            asm volatile("s_waitcnt vmcnt(0)" ::: "memory");
        }
    } else if (threadIdx.x >= 64) work();
    __syncthreads();
}
struct ConvArgs { bf16* P; bf16* XBC; const float *conv_w, *conv_b, *qnw, *knw; const int* pos; };
__device__ __forceinline__ void cvt8(const v4u r, float (&f)[8]) { f[0] = bf_lo(r.x); f[1] = bf_hi(r.x); f[2] = bf_lo(r.y); f[3] = bf_hi(r.y); f[4] = bf_lo(r.z); f[5] = bf_hi(r.z); f[6] = bf_lo(r.w); f[7] = bf_hi(r.w); }
__device__ __forceinline__ void conv_phase(const Frame& F, const ConvArgs& A) {
    for (int item = F.vcu; item < BATCH * NCHUNK; item += F.G) {
        const int b = item / NCHUNK, c = item % NCHUNK;
        const size_t rowb = (size_t)b * SEQ;
        {
            const int cg8 = F.tid & 127, ch = cg8 * 8;
            float w[5][8], bias[8];
#pragma unroll
            for (int k = 0; k < 5; ++k) { const f32x4 a = *(const f32x4*)(A.conv_w + k * 1024 + ch), d = *(const f32x4*)(A.conv_w + k * 1024 + ch + 4);
                w[k][0] = a.x; w[k][1] = a.y; w[k][2] = a.z; w[k][3] = a.w; w[k][4] = d.x; w[k][5] = d.y; w[k][6] = d.z; w[k][7] = d.w; }
            { const f32x4 a = *(const f32x4*)(A.conv_b + ch), d = *(const f32x4*)(A.conv_b + ch + 4); bias[0] = a.x; bias[1] = a.y; bias[2] = a.z; bias[3] = a.w; bias[4] = d.x; bias[5] = d.y; bias[6] = d.z; bias[7] = d.w; }
#pragma unroll 1
            for (int it = 0; it < 4; ++it) {
                const int t0 = c * CH + ((F.tid >> 7) + 4 * it) * 8;
                v4u rows[12];
#pragma unroll
                for (int j = 0; j < 12; ++j) { const int t = t0 - 2 + j; rows[j] = (v4u){0u, 0u, 0u, 0u}; if (t >= 0 && t < SEQ) rows[j] = *(const v4u*)(A.P + (rowb + t) * NPROJ + PXBC + ch); }
#pragma unroll
                for (int i = 0; i < 8; ++i) {
                    float f0[8], f1[8], f2[8], f3[8], f4[8], o[8];
                    cvt8(rows[i], f0); cvt8(rows[i + 1], f1); cvt8(rows[i + 2], f2); cvt8(rows[i + 3], f3); cvt8(rows[i + 4], f4);
#pragma unroll
                    for (int j = 0; j < 8; ++j) { const float v = bias[j] + w[0][j] * f0[j] + w[1][j] * f1[j] + w[2][j] * f2[j] + w[3][j] * f3[j] + w[4][j] * f4[j]; o[j] = silu_f(v); }
                    v4u ov; ov.x = pk2(o[0], o[1]); ov.y = pk2(o[2], o[3]); ov.z = pk2(o[4], o[5]); ov.w = pk2(o[6], o[7]);
                    *(v4u*)(A.XBC + (rowb + t0 + i) * 1024 + ch) = ov;
                }
            }
        }
#pragma unroll 1
        for (int it4 = 0; it4 < 5; ++it4) {
            v4u raw[4];
#pragma unroll
            for (int u = 0; u < 4; ++u) { const int sidx = F.tid + NTHR * (4 * it4 + u), tok = sidx / 80, slot = sidx % 80; raw[u] = *(const v4u*)(A.P + (rowb + c * CH + tok) * NPROJ + PQ + slot * 8); }
#pragma unroll
            for (int u = 0; u < 4; ++u) {
                const int sidx = F.tid + NTHR * (4 * it4 + u), tok = sidx / 80, slot = sidx % 80, head = slot >> 3, part = slot & 7;
                const int t = c * CH + tok;
                bf16* p = A.P + (rowb + t) * NPROJ + PQ + slot * 8;
                float v[8]; cvt8(raw[u], v);
                float ss = 0.f;
#pragma unroll
                for (int j = 0; j < 8; ++j) ss += v[j] * v[j];
                ss += __shfl_xor(ss, 1); ss += __shfl_xor(ss, 2); ss += __shfl_xor(ss, 4);
                const float rstd = rsqrtf(ss * (1.f / 64.f) + EPS);
                const float* nw = (head < 8 ? A.qnw : A.knw) + part * 8;
                const f32x4 w0 = *(const f32x4*)nw, w1 = *(const f32x4*)(nw + 4);
                v[0] *= rstd * w0.x; v[1] *= rstd * w0.y; v[2] *= rstd * w0.z; v[3] *= rstd * w0.w; v[4] *= rstd * w1.x; v[5] *= rstd * w1.y; v[6] *= rstd * w1.z; v[7] *= rstd * w1.w;
                float oth[8];
#pragma unroll
                for (int j = 0; j < 8; ++j) oth[j] = __shfl_xor(v[j], 1);
                if (part < 2) {
                    const float posf = (float)A.pos[rowb + t];
                    const float sgn = part == 0 ? -1.f : 1.f;
                    const float inv[8] = {1.0f, 0.19392274f, 0.03760603f, 0.0072926646f, 0.0014142136f, 0.00027424819f, 5.3182957e-05f, 1.0313385e-05f};
#pragma unroll
                    for (int j = 0; j < 8; ++j) {
                        const float ang = posf * inv[j];
                        const float nrev = rintf(ang * 0.15915494309189535f);
                        float rr = fmaf(-nrev, 6.2831855f, ang); rr = fmaf(-nrev, -1.7484555e-7f, rr);
                        const float sn = __sinf(rr), cs = __cosf(rr);
                        v[j] = v[j] * cs + sgn * oth[j] * sn;
                    }
                }
                const float sc = head < 8 ? QSCALE : 1.0f;
                v4u ov; ov.x = pk2(v[0] * sc, v[1] * sc); ov.y = pk2(v[2] * sc, v[3] * sc); ov.z = pk2(v[4] * sc, v[5] * sc); ov.w = pk2(v[6] * sc, v[7] * sc);
                *(v4u*)p = ov;
            }
        }
    }
}
template <int NCOL>
__device__ __forceinline__ void stage_load(const Frame& F, v4u* tmp, const bf16* src, size_t row0, int src_pitch, int col0) {
    constexpr int CPR = NCOL / 8, PER = 128 * CPR / NTHR;
#pragma unroll
    for (int j = 0; j < PER; ++j) { const int i = F.tid + NTHR * j, r = i / CPR, cc = i % CPR; tmp[j] = *(const v4u*)(src + (row0 + r) * src_pitch + col0 + cc * 8); }
}
template <int NCOL>
__device__ __forceinline__ void stage_store(const Frame& F, const v4u* tmp, LAS unsigned char* dst, int dst_pitch) {
    constexpr int CPR = NCOL / 8, PER = 128 * CPR / NTHR;
#pragma unroll
    for (int j = 0; j < PER; ++j) { const int i = F.tid + NTHR * j, r = i / CPR, cc = i % CPR; *(LAS v4u*)(dst + r * dst_pitch + cc * 16) = tmp[j]; }
}
__device__ __forceinline__ void scan128(float& lo, float& hi, float& total, int lane) {
#pragma unroll
    for (int o = 1; o < 64; o <<= 1) { const float a = __shfl_up(lo, o), b2 = __shfl_up(hi, o); if (lane >= o) { lo += a; hi += b2; } }
    const float tl = __shfl(lo, 63); hi += tl; total = __shfl(hi, 63);
}
struct SsdArgs { const bf16* P; const bf16* XBC; const float* DT; const float *a_log, *d_skip, *ssd_nw; bf16* ST; float* CD; bf16* Y; float* ssq; };

__device__ __forceinline__ void ssd_states_phase(const Frame& F, const SsdArgs& A) {
    LAS unsigned char* Xs = F.lds + L_XS; LAS unsigned char* Bs = F.lds + L_BS; LAS float* wts = (LAS float*)(F.lds + L_ARR);
    const int lane = F.lane, h5 = lane >> 5;
    for (int item = F.vcu; item < BATCH * NCHUNK * 2; item += F.G) {
        const int g = item / (BATCH * NCHUNK), bc = item % (BATCH * NCHUNK), b = bc / NCHUNK, c = bc % NCHUNK;
        const size_t row0 = (size_t)b * SEQ + (size_t)c * CH;
        __syncthreads();
        const int hh = F.wave & 3, dir = F.wave >> 2, h = 4 * g + hh;
        const float dt0 = A.DT[(row0 + lane) * 16 + dir * 8 + h], dt1 = A.DT[(row0 + 64 + lane) * 16 + dir * 8 + h];
        {
            v4u tx[8], tb[4];
            stage_load<256>(F, tx, A.XBC, row0, 1024, g * 256); stage_load<128>(F, tb, A.XBC, row0, 1024, 512 + g * 128);
            stage_store<256>(F, tx, Xs, XS_PITCH); stage_store<128>(F, tb, Bs, BS_PITCH);
        }
        {
            const float a = -__expf(A.a_log[dir * 8 + h]);
            const float da0 = dt0 * a, da1 = dt1 * a;
            float p0 = da0, p1 = da1, tot; scan128(p0, p1, tot, lane);
            float w0, w1;
            if (dir == 0) { w0 = __expf(tot - p0) * dt0; w1 = __expf(tot - p1) * dt1; }
            else          { w0 = __expf(p0 - da0) * dt0; w1 = __expf(p1 - da1) * dt1; }
            wts[F.wave * 128 + lane] = w0; wts[F.wave * 128 + 64 + lane] = w1;
            if (lane == 0) A.CD[(bc * 2 + dir) * 8 + h] = __expf(tot);
        }
        __syncthreads();
        f32x16 acc[4][2];
#pragma unroll
        for (int nt = 0; nt < 4; ++nt)
#pragma unroll
            for (int pt = 0; pt < 2; ++pt)
#pragma unroll
                for (int r = 0; r < 16; ++r) acc[nt][pt][r] = 0.f;
#pragma unroll 2
        for (int ks = 0; ks < 8; ++ks) {
            const int s0 = 16 * ks + 8 * h5;
            const f32x4 wa = *(const LAS f32x4*)(wts + F.wave * 128 + s0), wb = *(const LAS f32x4*)(wts + F.wave * 128 + s0 + 4);
            const float wv[8] = {wa.x, wa.y, wa.z, wa.w, wb.x, wb.y, wb.z, wb.w};
            bf16x8 xb[2];
#pragma unroll
            for (int pt = 0; pt < 2; ++pt) {
                const bf16x8 raw = frag_tr(Xs, XS_PITCH, s0, s0 + 4, hh * 64 + 32 * pt, lane);
                v4u pk;
                pk.x = pk2(__uint_as_float(((unsigned)(unsigned short)raw[0]) << 16) * wv[0], __uint_as_float(((unsigned)(unsigned short)raw[1]) << 16) * wv[1]);
                pk.y = pk2(__uint_as_float(((unsigned)(unsigned short)raw[2]) << 16) * wv[2], __uint_as_float(((unsigned)(unsigned short)raw[3]) << 16) * wv[3]);
                pk.z = pk2(__uint_as_float(((unsigned)(unsigned short)raw[4]) << 16) * wv[4], __uint_as_float(((unsigned)(unsigned short)raw[5]) << 16) * wv[5]);
                pk.w = pk2(__uint_as_float(((unsigned)(unsigned short)raw[6]) << 16) * wv[6], __uint_as_float(((unsigned)(unsigned short)raw[7]) << 16) * wv[7]);
                xb[pt] = __builtin_bit_cast(bf16x8, pk);
            }
#pragma unroll
            for (int nt = 0; nt < 4; ++nt) {
                const bf16x8 bt = frag_tr_perm(Bs, BS_PITCH, s0, s0 + 4, 64 * (nt >> 1), nt & 1, lane);
#pragma unroll
                for (int pt = 0; pt < 2; ++pt) acc[nt][pt] = mfma32(bt, xb[pt], acc[nt][pt]);
            }
        }
        bf16* st = A.ST + ((size_t)((bc * 2 + dir) * 8 + h)) * 8192;
#pragma unroll
        for (int nt = 0; nt < 4; ++nt)
#pragma unroll
            for (int pt = 0; pt < 2; ++pt) { bf16* dst = st + (32 * pt + (lane & 31)) * 128 + 64 * (nt >> 1) + 32 * h5 + 16 * (nt & 1);
                v4u w0, w1; w0.x = pk2(acc[nt][pt][0], acc[nt][pt][1]); w0.y = pk2(acc[nt][pt][2], acc[nt][pt][3]); w0.z = pk2(acc[nt][pt][4], acc[nt][pt][5]); w0.w = pk2(acc[nt][pt][6], acc[nt][pt][7]);
                w1.x = pk2(acc[nt][pt][8], acc[nt][pt][9]); w1.y = pk2(acc[nt][pt][10], acc[nt][pt][11]); w1.z = pk2(acc[nt][pt][12], acc[nt][pt][13]); w1.w = pk2(acc[nt][pt][14], acc[nt][pt][15]);
                *(v4u*)dst = w0; *(v4u*)(dst + 8) = w1; }
    }
}

__device__ __forceinline__ void ssd_scan_phase(const Frame& F, const SsdArgs& A) {
    const int gt = F.vcu * NTHR + F.tid, NT = F.G * NTHR;
    for (int e = gt; e < BATCH * 2 * 8 * 64 * 32; e += NT) {
        const int n4 = e & 31, p = (e >> 5) & 63, h = (e >> 11) & 7, dir = (e >> 14) & 1, b = e >> 15;
        float st[4] = {0.f, 0.f, 0.f, 0.f};
        for (int c8 = 0; c8 < NCHUNK; c8 += 16) {
            v2u v[16]; float cd[16];
#pragma unroll
            for (int j = 0; j < 16; ++j) { const int c = dir == 0 ? (c8 + j) : (NCHUNK - 1 - c8 - j); const int bc = b * NCHUNK + c;
                v[j] = *(const v2u*)(A.ST + ((size_t)((bc * 2 + dir) * 8 + h)) * 8192 + p * 128 + 4 * n4); cd[j] = A.CD[(bc * 2 + dir) * 8 + h]; }
#pragma unroll
            for (int j = 0; j < 16; ++j) { const int c = dir == 0 ? (c8 + j) : (NCHUNK - 1 - c8 - j); const int bc = b * NCHUNK + c;
                v2u o; o.x = pk2(st[0], st[1]); o.y = pk2(st[2], st[3]);
                *(v2u*)(A.ST + ((size_t)((bc * 2 + dir) * 8 + h)) * 8192 + p * 128 + 4 * n4) = o;
                st[0] = st[0] * cd[j] + bf_lo(v[j].x); st[1] = st[1] * cd[j] + bf_hi(v[j].x); st[2] = st[2] * cd[j] + bf_lo(v[j].y); st[3] = st[3] * cd[j] + bf_hi(v[j].y); }
        }
    }
}
struct AttnArgs { const bf16* P; bf16* Y; const float* sink; const float *qnw, *knw; const float* ssq; };
__device__ __forceinline__ void attn_phase(const Frame& F, const AttnArgs& A) {
    LAS unsigned char* Ks = F.lds; LAS unsigned char* Vs = F.lds + 384 * KV_PITCH;
    const int lane = F.lane, h5 = lane >> 5, r32 = lane & 31;
    float mref;
    { float a = fabsf(A.qnw[lane]), b2 = fabsf(A.knw[lane]);
#pragma unroll
      for (int o = 1; o < 64; o <<= 1) { a = fmaxf(a, __shfl_xor(a, o)); b2 = fmaxf(b2, __shfl_xor(b2, o)); }
      mref = fminf(8.0f * LOG2E * a * b2 * 1.01f + 0.5f, 100.f); }
    v4u kt[6], vt[6];
    auto kv_fetch = [&](int item) {
        const int kvh = item / (BATCH * NCHUNK), bq = item % (BATCH * NCHUNK), b = bq / NCHUNK, qb = bq % NCHUNK; const size_t rowb = (size_t)b * SEQ;
#pragma unroll
        for (int jj = 0; jj < 6; ++jj) { const int i = F.tid + NTHR * jj, r = i >> 3, cc = i & 7, j = qb * 128 - 128 + r;
            kt[jj] = (v4u){0u, 0u, 0u, 0u}; vt[jj] = (v4u){0u, 0u, 0u, 0u};
            if (j >= 0 && j < SEQ) { const bf16* src = A.P + (rowb + j) * NPROJ + kvh * 64 + cc * 8; kt[jj] = *(const v4u*)(src + PK); vt[jj] = *(const v4u*)(src + PV); } }
    };
    if (F.vcu < BATCH * NCHUNK * 2) kv_fetch(F.vcu);
    for (int item = F.vcu; item < BATCH * NCHUNK * 2; item += F.G) {
        const int kvh = item / (BATCH * NCHUNK), bq = item % (BATCH * NCHUNK), b = bq / NCHUNK, qb = bq % NCHUNK;
        const size_t rowb = (size_t)b * SEQ;
        __syncthreads();
#pragma unroll
        for (int jj = 0; jj < 6; ++jj) { const int i = F.tid + NTHR * jj, r = i >> 3, cc = i & 7;
            *(LAS v4u*)(Ks + r * KV_PITCH + cc * 16) = kt[jj]; *(LAS v4u*)(Vs + r * KV_PITCH + cc * 16) = vt[jj]; }
        __syncthreads();
        if (item + F.G < BATCH * NCHUNK * 2) kv_fetch(item + F.G);
        const int hq = kvh * 4 + (F.wave & 3), qhalf = F.wave >> 2;
        const float sinkl = A.sink[hq] * LOG2E;
#pragma unroll 1
        for (int qt = 0; qt < 2; ++qt) {
            const int o = 64 * qhalf + 32 * qt;
            const int ir = o + r32;
            bf16x8 qf[4];
            { const bf16* qp = A.P + (rowb + qb * 128 + ir) * NPROJ + PQ + hq * 64 + 8 * h5;
#pragma unroll
              for (int kd = 0; kd < 4; ++kd) qf[kd] = *(const bf16x8*)(qp + 16 * kd); }
            float lsum = h5 == 0 ? __builtin_amdgcn_exp2f(sinkl - mref) : 0.0f;
            f32x16 oacc[2];
#pragma unroll
            for (int r = 0; r < 16; ++r) { oacc[0][r] = 0.f; oacc[1][r] = 0.f; }
#pragma unroll 1
            for (int ks = 0; ks < 6; ++ks) {
                const int kstart = -128 + 64 * ks;
                if (kstart > o + 31 + 128 || kstart + 63 < o - 128) continue;
                f32x16 st[2];
#pragma unroll
                for (int kt = 0; kt < 2; ++kt) {
#pragma unroll
                    for (int r = 0; r < 16; ++r) st[kt][r] = -mref;
#pragma unroll
                    for (int kd = 0; kd < 4; ++kd) st[kt] = mfma32(frag_row(Ks, KV_PITCH, 64 * ks + 32 * kt, 16 * kd, lane), qf[kd], st[kt]);
                }
                const bool interior = (kstart >= o + 31 - 128) && (kstart + 63 <= o + 128) && (qb * 128 + kstart >= 0) && (qb * 128 + kstart + 63 < SEQ);
                if (!interior) {
#pragma unroll
                    for (int kt = 0; kt < 2; ++kt)
#pragma unroll
                        for (int r = 0; r < 16; ++r) { const int jr = kstart + 32 * kt + crow(r, h5); const int dlt = ir - jr; const int jg = qb * 128 + jr;
                            const bool ok = dlt <= 128 && dlt >= -128 && jg >= 0 && jg < SEQ;
                            st[kt][r] = ok ? st[kt][r] : -1e30f; }
                }
                float ps = 0.f;
#pragma unroll
                for (int kt = 0; kt < 2; ++kt)
#pragma unroll
                    for (int r = 0; r < 16; ++r) { const float p = __builtin_amdgcn_exp2f(st[kt][r]); st[kt][r] = p; ps += p; }
                lsum += ps;
#pragma unroll
                for (int kt = 0; kt < 2; ++kt)
#pragma unroll
                    for (int s2 = 0; s2 < 2; ++s2) {
                        const bf16x8 pf = pack_step(st[kt], s2);
                        const int key0 = 64 * ks + 32 * kt + 16 * s2 + 4 * h5;
#pragma unroll
                        for (int dt = 0; dt < 2; ++dt) oacc[dt] = mfma32(frag_tr_perm(Vs, KV_PITCH, key0, key0 + 8, 0, dt, lane), pf, oacc[dt]);
                    }
            }
            lsum += __shfl_xor(lsum, 32);
            const float inv = sqrtf(__hip_atomic_load(A.ssq + rowb + qb * 128 + ir, __ATOMIC_RELAXED, __HIP_MEMORY_SCOPE_AGENT) * (1.f / 512.f) + EPS) / lsum;
            bf16* yp = A.Y + (rowb + qb * 128 + ir) * 1024 + 512 + hq * 64 + 32 * h5;
#pragma unroll
            for (int dt = 0; dt < 2; ++dt) {
                v4u w0, w1; w0.x = pk2(oacc[dt][0] * inv, oacc[dt][1] * inv); w0.y = pk2(oacc[dt][2] * inv, oacc[dt][3] * inv); w0.z = pk2(oacc[dt][4] * inv, oacc[dt][5] * inv); w0.w = pk2(oacc[dt][6] * inv, oacc[dt][7] * inv);
                w1.x = pk2(oacc[dt][8] * inv, oacc[dt][9] * inv); w1.y = pk2(oacc[dt][10] * inv, oacc[dt][11] * inv); w1.z = pk2(oacc[dt][12] * inv, oacc[dt][13] * inv); w1.w = pk2(oacc[dt][14] * inv, oacc[dt][15] * inv);
                *(v4u*)(yp + 16 * dt) = w0; *(v4u*)(yp + 16 * dt + 8) = w1; }
        }
    }
}
__device__ __forceinline__ void ssd_out_phase(const Frame& F, const SsdArgs& A) {
    LAS unsigned char* Xs = F.lds + L_XS; LAS unsigned char* Bs = F.lds + L_BS; LAS unsigned char* Cs = F.lds + L_CS;
    LAS float* arr = (LAS float*)(F.lds + L_ARR);
    const int lane = F.lane, h5 = lane >> 5, r32 = lane & 31;
    const int hh = F.wave & 3, lhalf = F.wave >> 2;
    for (int item = F.vcu; item < BATCH * NCHUNK * 2; item += F.G) {
        const int g = item / (BATCH * NCHUNK), bc = item % (BATCH * NCHUNK), b = bc / NCHUNK, c = bc % NCHUNK;
        const size_t row0 = (size_t)b * SEQ + (size_t)c * CH;
        const int h = 4 * g + hh;
        __syncthreads();
        {
            const int dir = F.wave >> 2;
            const float dt0 = A.DT[(row0 + lane) * 16 + dir * 8 + h], dt1 = A.DT[(row0 + 64 + lane) * 16 + dir * 8 + h];
            {
                v4u tx[8], tb[4], tc[4];
                stage_load<256>(F, tx, A.XBC, row0, 1024, g * 256); stage_load<128>(F, tb, A.XBC, row0, 1024, 512 + g * 128); stage_load<128>(F, tc, A.XBC, row0, 1024, 768 + g * 128);
                stage_store<256>(F, tx, Xs, XS_PITCH); stage_store<128>(F, tb, Bs, BS_PITCH); stage_store<128>(F, tc, Cs, BS_PITCH);
            }
            const float a = -__expf(A.a_log[dir * 8 + h]);
            const float da0 = dt0 * a, da1 = dt1 * a;
            float p0 = da0, p1 = da1, tot; scan128(p0, p1, tot, lane);
            LAS float* cs = arr + (2 * dir) * 512 + hh * 128; LAS float* dts = arr + (2 * dir + 1) * 512 + hh * 128;
            if (dir == 0) { cs[lane] = p0; cs[64 + lane] = p1; } else { cs[lane] = tot - p0 + da0; cs[64 + lane] = tot - p1 + da1; }
            dts[lane] = dt0; dts[64 + lane] = dt1;
        }
        __syncthreads();
        const float dsk = A.d_skip[h];
        const LAS float* csf = arr + hh * 128; const LAS float* dtf = arr + 512 + hh * 128; const LAS float* rsb = arr + 1024 + hh * 128; const LAS float* dtb = arr + 1536 + hh * 128;
#pragma unroll 1
        for (int lt2 = 0; lt2 < 2; ++lt2) {
            const int lt = 2 * lhalf + lt2, l = 32 * lt + r32;
            const float my_cs = csf[l], my_rs = rsb[l];
            const int ch0 = h * 64 + 32 * h5;
            v4u zz[4];
            { const bf16* zp = A.P + (row0 + l) * NPROJ + PZ + ch0;
#pragma unroll
              for (int q = 0; q < 4; ++q) zz[q] = *(const v4u*)(zp + 8 * q); }
            f32x16 yacc[2];
#pragma unroll
            for (int r = 0; r < 16; ++r) { yacc[0][r] = 0.f; yacc[1][r] = 0.f; }
            bf16x8 cf[8];
#pragma unroll
            for (int kn = 0; kn < 8; ++kn) cf[kn] = frag_row(Cs, BS_PITCH, 32 * lt, 16 * kn, lane);
#pragma unroll 1
            for (int st = 0; st < 4; ++st) {
                f32x16 cbt;
#pragma unroll
                for (int r = 0; r < 16; ++r) cbt[r] = 0.f;
#pragma unroll
                for (int kn = 0; kn < 8; ++kn) cbt = mfma32(frag_row(Bs, BS_PITCH, 32 * st, 16 * kn, lane), cf[kn], cbt);
#pragma unroll
                for (int g4 = 0; g4 < 4; ++g4) {
                    const int sb = 32 * st + 8 * g4 + 4 * h5;
                    const f32x4 c4 = *(const LAS f32x4*)(csf + sb), d4 = *(const LAS f32x4*)(dtf + sb), r4 = *(const LAS f32x4*)(rsb + sb), e4 = *(const LAS f32x4*)(dtb + sb);
#pragma unroll
                    for (int i = 0; i < 4; ++i) { const int s = sb + i; const bool fwd = s <= l;
                        const float e = fwd ? (my_cs - c4[i]) : (my_rs - r4[i]); const float dtv = fwd ? d4[i] : e4[i];
                        float mval = cbt[4 * g4 + i] * __expf(e) * dtv; if (s == l) mval += dsk; cbt[4 * g4 + i] = mval; }
                }
#pragma unroll
                for (int s2 = 0; s2 < 2; ++s2) {
                    const bf16x8 mf = pack_step(cbt, s2);
                    const int sA = 32 * st + 16 * s2 + 4 * h5;
#pragma unroll
                    for (int pt = 0; pt < 2; ++pt) yacc[pt] = mfma32(frag_tr_perm(Xs, XS_PITCH, sA, sA + 8, hh * 64, pt, lane), mf, yacc[pt]);
                }
            }
#pragma unroll 1
            for (int dir = 0; dir < 2; ++dir) {
                const bf16* stp = A.ST + ((size_t)((bc * 2 + dir) * 8 + h)) * 8192 + 8 * h5;
                bf16x8 sf[2][8];
#pragma unroll
                for (int pt = 0; pt < 2; ++pt)
#pragma unroll
                    for (int kn = 0; kn < 8; ++kn) sf[pt][kn] = *(const bf16x8*)(stp + perm_row(r32, pt) * 128 + 16 * kn);
                const float ef = __expf(dir == 0 ? my_cs : my_rs);
#pragma unroll
                for (int kn = 0; kn < 8; ++kn) {
                    const v4u cw = __builtin_bit_cast(v4u, cf[kn]);
                    v4u sw; sw.x = pk2(bf_lo(cw.x) * ef, bf_hi(cw.x) * ef); sw.y = pk2(bf_lo(cw.y) * ef, bf_hi(cw.y) * ef); sw.z = pk2(bf_lo(cw.z) * ef, bf_hi(cw.z) * ef); sw.w = pk2(bf_lo(cw.w) * ef, bf_hi(cw.w) * ef);
                    const bf16x8 cs8 = __builtin_bit_cast(bf16x8, sw);
#pragma unroll
                    for (int pt = 0; pt < 2; ++pt) yacc[pt] = mfma32(sf[pt][kn], cs8, yacc[pt]);
                }
            }
            {
                bf16* yp = A.Y + (row0 + l) * 1024 + ch0;
                float sq = 0.f;
#pragma unroll
                for (int q = 0; q < 4; ++q) {
                    const int pt = q >> 1, r0 = 8 * (q & 1);
                    const f32x4 nw0 = *(const f32x4*)(A.ssd_nw + ch0 + 8 * q), nw1 = *(const f32x4*)(A.ssd_nw + ch0 + 8 * q + 4);
                    float zf[8]; cvt8(zz[q], zf);
                    float y[8];
#pragma unroll
                    for (int i = 0; i < 8; ++i) { y[i] = yacc[pt][r0 + i] * silu_f(zf[i]); sq += y[i] * y[i]; }
                    v4u w; w.x = pk2(y[0] * nw0.x, y[1] * nw0.y); w.y = pk2(y[2] * nw0.z, y[3] * nw0.w); w.z = pk2(y[4] * nw1.x, y[5] * nw1.y); w.w = pk2(y[6] * nw1.z, y[7] * nw1.w);
                    *(v4u*)(yp + 8 * q) = w;
                }
                sq += __shfl_xor(sq, 32);
                if (h5 == 0) __hip_atomic_fetch_add(A.ssq + row0 + l, sq, __ATOMIC_RELAXED, __HIP_MEMORY_SCOPE_AGENT);
            }
        }
    }
}
#ifndef MK_ONE_LAUNCH
#define MK_ONE_LAUNCH 1
#endif
constexpr int NPHASE = 11;
struct Args { const float* in[25]; float* out; unsigned char* ws; int ph_lo, ph_hi; };
__global__ void __launch_bounds__(NTHR, 2) hybrid_fwd(Args args) {
    extern __shared__ __attribute__((aligned(16))) unsigned char lds_raw[];
    Frame F;
    F.lds = (LAS unsigned char*)lds_raw;
    F.tid = threadIdx.x; F.lane = F.tid & 63; F.wave = __builtin_amdgcn_readfirstlane(F.tid >> 6);
    F.G = gridDim.x; { const int bx = blockIdx.x; F.vcu = (F.G % 8 == 0) ? (bx % 8) * (F.G / 8) + bx / 8 : bx; }
    unsigned char* ws = args.ws;
    const float* x = args.in[0]; const float* cvec = args.in[1]; const int* pos = (const int*)args.in[2];
    const float *w_ada = args.in[3], *b_ada = args.in[4], *norm_ffn1 = args.in[5], *ffn1_wg = args.in[6], *ffn1_wu = args.in[7], *ffn1_wd = args.in[8], *norm_mix = args.in[9], *w_in = args.in[10];
    const float *conv_w = args.in[11], *conv_b = args.in[12], *dt_bias = args.in[13], *a_log = args.in[14], *d_skip = args.in[15], *ssd_nw = args.in[16], *qnw = args.in[17], *knw = args.in[18], *sink = args.in[19];
    const float *w_out = args.in[20], *norm_ffn2 = args.in[21], *ffn2_wg = args.in[22], *ffn2_wu = args.in[23], *ffn2_wd = args.in[24];
    float* out = args.out;
    float* mod = (float*)(ws + WS_CTL + CTL_MOD);
    bf16 *WGU1 = (bf16*)(ws + WS_WGU1), *WD1 = (bf16*)(ws + WS_WD1), *WINB = (bf16*)(ws + WS_WINB), *WOUT = (bf16*)(ws + WS_WOUT), *WGU2B = (bf16*)(ws + WS_WGU2B), *WD2 = (bf16*)(ws + WS_WD2);
    float* DT = (float*)(ws + WS_DT); float* CD = (float*)(ws + WS_CD); float* ssq = (float*)(ws + WS_CTL + CTL_SSQ); float* rssq1 = (float*)(ws + WS_CTL + CTL_RSSQ1); float* rssq2 = (float*)(ws + WS_CTL + CTL_RSSQ2); float* sW2 = (float*)(ws + WS_CTL + CTL_SW2); float* sW3 = (float*)(ws + WS_CTL + CTL_SW3);
    bf16 *U = (bf16*)(ws + WS_U), *H = (bf16*)(ws + WS_H), *P = (bf16*)(ws + WS_H), *XBC = (bf16*)out, *ST = (bf16*)out + (size_t)M * 1024, *X1 = (bf16*)(ws + WS_X1);
    const int lo = args.ph_lo, hi = args.ph_hi;
    cg::grid_group grid = cg::this_grid();
    volatile LAS unsigned* xbst = (volatile LAS unsigned*)(F.lds + L_END);
    if (F.tid < 2) xbst[F.tid] = 0u;
    __syncthreads();
    XcdBarrier bar; bar.bar = (unsigned*)(ws + WS_CTL + CTL_BAR); bar.x = 0; bar.st = xbst;
    if (hi - lo > 1) bar = xcd_barrier_post((unsigned*)(ws + WS_CTL + CTL_BAR), xbst);
#ifndef PHM
#define PHM 0xffff
#endif
#ifndef WGM_N4
#define WGM_N4 2
#endif
#ifndef EPI_ALIGN
#define EPI_ALIGN true
#endif
#ifndef DUPM
#define DUPM 0
#endif
#define IN(k) (((PHM >> (k)) & 1) && lo <= (k) && (k) < hi)
#define SEAM(k) do { if (IN(k) && IN((k) + 1)) xcd_barrier(bar); } while (0)
#define DUP(k) (((DUPM >> (k)) & 1) != 0)
#define SEAMW(k, k0) do { if (IN(k) && IN((k) + 1)) { if (prep_in_bar) { const int kk0 = (k0); xcd_barrier_w(bar, [&]() { prep_one(F, PA, kk0 + F.wave - 1); }); } else xcd_barrier(bar); } } while (0)
#define PHASEW(k, k0, ...) if (IN(k)) { __VA_ARGS__; } SEAMW(k, k0);
#define PHASE(k, ...) if (IN(k)) { __VA_ARGS__; if (DUP(k)) { xcd_barrier(bar); __VA_ARGS__; } } SEAM(k);
    if (lo > hi) grid.sync();
    PHASE(0, { P0Args A{ffn1_wg, ffn1_wu, ffn1_wd, w_out, ffn2_wd, cvec, w_ada, b_ada, WGU1, WD1, WOUT, WD2, mod}; p0_prologue(F, A); })
    const PrepArgs PA{w_in, ffn2_wg, ffn2_wu, norm_mix, norm_ffn2, mod, WINB, WGU2B, sW2, sW3};
    const bool prep_in_bar = (PREP_ITEMS + F.G - 1) / F.G <= 21 && lo == 0 && hi == NPHASE;
    PHASEW(1, 0, { norm_phase<false>(F, x, norm_ffn1, mod, 0, 1, U); prep_phase(F, PA, !prep_in_bar); })
    PHASEW(2, 7, { pg8::Gemm g{U, WGU1, M, NGU, D, 0, 1 << 30}; pg8::StaticOrder S; S.init(M, NGU, F.G, (int)blockIdx.x); pg8::EpiSwiGLU<false> E{H, nullptr, nullptr, DFF, 0, SEQ};
        pg8::gemm_phase<pg8::EpiSwiGLU<false>, pg8::StaticOrder, true, true>(F.lds, g, S, E); })
    PHASEW(3, 14, { pg8::Gemm g{H, WD1, M, D, DFF, 0, 1 << 30}; pg8::StaticOrder S; S.init(M, D, F.G, (int)blockIdx.x, WGM_N4); pg8::EpiResid<false, true, false, true> E{x, X1, mod + 2 * D, nullptr, rssq1, D, NMOD, SEQ, 0.5f, 0.f};
        pg8::gemm_phase<pg8::EpiResid<false, true, false, true>, pg8::StaticOrder, EPI_ALIGN, true>(F.lds, g, S, E); })
    PHASE(4, { pg8::Gemm g{X1, WINB, M, NPROJ_PAD, D, (size_t)NPROJ_PAD * D * 2, SEQ / 256}; pg8::StaticOrder S; S.init(M, NPROJ_PAD, F.G, (int)blockIdx.x); pg8::EpiProj E{P, DT, dt_bias, rssq1, sW2, NPROJ, NPROJ / 256, NPROJ_PAD, SEQ};
        pg8::gemm_phase<pg8::EpiProj, pg8::StaticOrder, true, true>(F.lds, g, S, E); })
    PHASE(5, { ConvArgs A{P, XBC, conv_w, conv_b, qnw, knw, pos}; conv_phase(F, A); if (F.G != BATCH * NCHUNK) xcd_barrier(bar); else __syncthreads();
               SsdArgs B{P, XBC, DT, a_log, d_skip, ssd_nw, ST, CD, U, ssq}; ssd_states_phase(F, B); })
    PHASE(6, { SsdArgs A{P, XBC, DT, a_log, d_skip, ssd_nw, ST, CD, U, ssq}; ssd_scan_phase(F, A); })
    PHASE(7, { SsdArgs A{P, XBC, DT, a_log, d_skip, ssd_nw, ST, CD, U, ssq}; ssd_out_phase(F, A); if (F.G != BATCH * NCHUNK) xcd_barrier(bar); else __syncthreads();
               AttnArgs B{P, U, sink, qnw, knw, ssq}; attn_phase(F, B); })
    PHASE(8, { pg8::Gemm g{U, WOUT, M, D, D, 0, 1 << 30}; pg8::StaticOrder S; S.init(M, D, F.G, (int)blockIdx.x, WGM_N4); pg8::EpiResid<true, true, true, true> E{X1, X1, mod + 5 * D, ssq, rssq2, D, NMOD, SEQ, 1.0f, 1.f / 512.f};
        pg8::gemm_phase<pg8::EpiResid<true, true, true, true>, pg8::StaticOrder, EPI_ALIGN, true>(F.lds, g, S, E); })
    PHASE(9, { pg8::Gemm g{X1, WGU2B, M, NGU, D, (size_t)NGU * D * 2, SEQ / 256}; pg8::StaticOrder S; S.init(M, NGU, F.G, (int)blockIdx.x); pg8::EpiSwiGLU<true> E{H, rssq2, sW3, DFF, NGU, SEQ};
        pg8::gemm_phase<pg8::EpiSwiGLU<true>, pg8::StaticOrder, true, true>(F.lds, g, S, E); })
    PHASE(10, { pg8::Gemm g{H, WD2, M, D, DFF, 0, 1 << 30}; pg8::StaticOrder S; S.init(M, D, F.G, (int)blockIdx.x, WGM_N4); pg8::EpiResid<true, false> E{X1, out, mod + 8 * D, nullptr, nullptr, D, NMOD, SEQ, 0.5f, 0.f};
        pg8::gemm_phase<pg8::EpiResid<true, false>, pg8::StaticOrder, EPI_ALIGN, true>(F.lds, g, S, E); })
#undef IN
#undef SEAM
}

extern "C" void kernel_launch(void* const* d_in, const int* in_sizes, int n_in, void* d_out, int out_size, void* d_ws, size_t ws_size, hipStream_t stream) {
    static int grid = 0;
    if (grid == 0) {
        if (n_in != 25 || in_sizes[0] != M * D || out_size != M * D || ws_size < WS_END) { fprintf(stderr, "kernel_launch: unexpected shapes (n_in %d, in0 %d, out %d, ws %zu)\n", n_in, n_in > 0 ? in_sizes[0] : -1, out_size, ws_size); grid = -1; return; }
        int dev = 0, cus = 0, per_cu = 0;
        if (hipGetDevice(&dev) != hipSuccess || hipDeviceGetAttribute(&cus, hipDeviceAttributeMultiprocessorCount, dev) != hipSuccess) { grid = -1; return; }
        if (hipFuncSetAttribute((const void*)hybrid_fwd, hipFuncAttributeMaxDynamicSharedMemorySize, LDS_BYTES) != hipSuccess) { fprintf(stderr, "kernel_launch: hipFuncSetAttribute failed\n"); grid = -1; return; }
        if (hipOccupancyMaxActiveBlocksPerMultiprocessor(&per_cu, (const void*)hybrid_fwd, NTHR, LDS_BYTES) != hipSuccess || per_cu < 1) { fprintf(stderr, "kernel_launch: occupancy query says %d\n", per_cu); per_cu = 1; }
        (void)hipGetLastError();
        grid = cus * per_cu;
        if (grid > 256) grid = 256;
    }
    if (grid < 0) return;
    if (hipMemsetAsync((char*)d_ws + WS_CTL, 0, CTL_ZERO_BYTES, stream) != hipSuccess) { fprintf(stderr, "kernel_launch: memset failed\n"); return; }
    Args a{};
    for (int i = 0; i < 25; ++i) a.in[i] = (const float*)d_in[i];
    a.out = (float*)d_out; a.ws = (unsigned char*)d_ws;
#if MK_ONE_LAUNCH
    a.ph_lo = 0; a.ph_hi = NPHASE;
    void* kargs[] = {&a};
    hipError_t e = hipLaunchCooperativeKernel((const void*)hybrid_fwd, dim3(grid), dim3(NTHR), kargs, LDS_BYTES, stream);
    if (e != hipSuccess) fprintf(stderr, "kernel_launch: cooperative launch failed: %s (grid %d)\n", hipGetErrorString(e), grid);
#else
    for (int p = 0; p < NPHASE; ++p) { a.ph_lo = p; a.ph_hi = p + 1; hipLaunchKernelGGL(hybrid_fwd, dim3(grid), dim3(NTHR), LDS_BYTES, stream, a); }
#endif
}
```

```cpp
#include <hip/hip_runtime.h>
#include <hip/hip_cooperative_groups.h>
#include <cstdio>
#include <cstdint>
namespace cg = cooperative_groups;
namespace pg8 {
#define PG8_LAS __attribute__((address_space(3)))
typedef unsigned short bf16_t;
typedef short bf16x8 __attribute__((ext_vector_type(8)));
typedef float f32x4 __attribute__((ext_vector_type(4)));
typedef unsigned u32x4 __attribute__((ext_vector_type(4)));
constexpr int BM = 256, BK = 64, HALF = 128, HTB = HALF * BK * 2  , STAGE_BYTES = 8 * HTB, NXCD = 8, WGM = 2;

__host__ __device__ __forceinline__ int lds_byte(int r, int c) { const int st = (r >> 4) * 2 + (c >> 5), rr = r & 15, cc = c & 31, ob = rr * 64 + cc * 2; return st * 1024 + (ob ^ (((ob >> 9) & 1) << 5)); }
__host__ __device__ __forceinline__ void stage_rc(int b, int& R, int& C) { const int st = b / 1024, sb = b % 1024, swz = sb ^ (((sb >> 9) & 1) << 5); R = (st >> 1) * 16 + swz / 64; C = (st & 1) * 32 + (swz % 64) / 2; }
__host__ __device__ __forceinline__ int perm32(int rho) { const int n = rho >> 4, i = rho & 15; return 8 * (i >> 2) + 4 * n + (i & 3); }

struct Unit { int pm, pn; };
struct Gemm { const bf16_t* A; const bf16_t* Bt; int M, N, K; size_t bstep; int pmb; };

struct StaticOrder {
    int nM, nN, nwg, G, c, wgm;
    __host__ __device__ void init(int M, int N, int G_, int c_, int wgm_ = WGM) { nM = M / BM; nN = N / BM; nwg = nM * nN; G = G_; c = c_; wgm = wgm_; }
    __host__ __device__ bool next(int i, Unit& u) const {
        const long L = (long)i * G + c; if (L >= nwg) return false;
        int wgid = (int)L; { const int q = nwg / NXCD, r = nwg % NXCD, xcd = wgid % NXCD, off = wgid / NXCD; wgid = (xcd < r ? xcd * (q + 1) : r * (q + 1) + (xcd - r) * q) + off; }
        const int nig = wgm * nN, gid = wgid / nig, fm = gid * wgm, gsz = (nM - fm) < wgm ? (nM - fm) : wgm;
        u.pm = fm + ((wgid % nig) % gsz); u.pn = (wgid % nig) / gsz; return true;
    }
    __device__ __forceinline__ void a_ready(const Unit&) const {}
    __device__ __forceinline__ void done(const Unit&) const {}
};

__device__ __forceinline__ unsigned cvt_pk_bf16(float lo, float hi) { unsigned r; asm volatile("v_cvt_pk_bf16_f32 %0, %1, %2" : "=v"(r) : "v"(lo), "v"(hi)); return r; }
typedef int i32x4 __attribute__((ext_vector_type(4)));
template <bool I8> struct AccSel { typedef f32x4 type; };
template <> struct AccSel<true> { typedef i32x4 type; };
template <class Epi, class Sched, bool ALIGN_EPI = false, bool SP2 = false, bool I8 = false>
__device__ __forceinline__ void gemm_phase(PG8_LAS unsigned char* lds, const Gemm g, const Sched& S, const Epi& E) {
    const int tid = threadIdx.x, wid = __builtin_amdgcn_readfirstlane(tid >> 6), lane = tid & 63, wr = wid >> 2, wc = wid & 3, fr = lane & 15, fq = lane >> 4;
    const int K = g.K, nt = K / BK;
    unsigned voffA[2], voffB[2];
#pragma unroll
    for (int i = 0; i < 2; ++i) { int R, C; stage_rc(tid * 16 + i * 8192, R, C); const int Rb = Epi::PERM ? ((R & ~31) + perm32(R & 31)) : R;
        voffA[i] = (unsigned)(R * K + C) * 2u; voffB[i] = (unsigned)(Rb * K + C) * 2u; }
    const size_t kstep = (size_t)(BK * 2);
    const size_t hstep = (size_t)HALF * K * 2;
    const size_t tstep = 2 * hstep;
    const unsigned ldsw = (unsigned)wid * 1024u;
    const int aoff = lds_byte(wr * 64 + fr, fq * 8), boff = lds_byte(wc * 32 + fr, fq * 8);
#define PG8_SA(b, h) (((b) * 2 + (h)) * HTB)
#define PG8_SB(b, h) ((4 + (b) * 2 + (h)) * HTB)
#define PG8_STAGE(bufoff, gbase, voff) do { _Pragma("unroll") for (int _i = 0; _i < 2; ++_i) \
        __builtin_amdgcn_global_load_lds((const unsigned*)((const char*)(gbase) + (voff)[_i]), (PG8_LAS unsigned*)(lds + (bufoff) + ldsw + _i * 8192), 16, 0, 0); } while (0)
#define PG8_LDA(dst, b, h) do { _Pragma("unroll") for (int m = 0; m < 4; ++m) _Pragma("unroll") for (int k = 0; k < 2; ++k) dst[m][k] = *(const PG8_LAS bf16x8*)(lds + PG8_SA(b, h) + aoff + m * 2048 + k * 1024); } while (0)
#define PG8_LDB(dst, b, h) do { _Pragma("unroll") for (int n = 0; n < 2; ++n) _Pragma("unroll") for (int k = 0; k < 2; ++k) dst[n][k] = *(const PG8_LAS bf16x8*)(lds + PG8_SB(b, h) + boff + n * 2048 + k * 1024); } while (0)
#define PG8_MMA(ai, bj, At, Bt) do { __builtin_amdgcn_s_setprio(1); _Pragma("unroll") for (int m = 0; m < 4; ++m) _Pragma("unroll") for (int n = 0; n < 2; ++n) _Pragma("unroll") for (int k = 0; k < 2; ++k) \
        { if constexpr (I8) acc[ai][bj][m][n] = __builtin_amdgcn_mfma_i32_16x16x64_i8(__builtin_bit_cast(i32x4, Bt[n][k]), __builtin_bit_cast(i32x4, At[m][k]), acc[ai][bj][m][n], 0, 0, 0); \
          else acc[ai][bj][m][n] = __builtin_amdgcn_mfma_f32_16x16x32_bf16(Bt[n][k], At[m][k], acc[ai][bj][m][n], 0, 0, 0); } __builtin_amdgcn_s_setprio(0); } while (0)
#define PG8_WAIT_V(n) asm volatile("s_waitcnt vmcnt(" #n ")" ::: "memory")
#define PG8_WAIT_L(n) asm volatile("s_waitcnt lgkmcnt(" #n ")" ::: "memory")
#define PG8_BAR __builtin_amdgcn_s_barrier()
#define PG8_SCHED __builtin_amdgcn_sched_barrier(0)
    Unit cur, nxt; int ui = 0;
    if (!S.next(0, cur)) return;
    typedef typename AccSel<I8>::type AccT;
    AccT acc[2][2][4][2];
#pragma unroll
    for (int a = 0; a < 2; ++a)
#pragma unroll
        for (int b = 0; b < 2; ++b)
#pragma unroll
            for (int m = 0; m < 4; ++m)
#pragma unroll
                for (int n = 0; n < 2; ++n) acc[a][b][m][n] = (AccT){0, 0, 0, 0};
    bf16x8 At[4][2], B0[2][2], B1[2][2];
    const char* cA = (const char*)g.A + (size_t)cur.pm * tstep; const char* cB = (const char*)g.Bt + (size_t)cur.pn * tstep + (size_t)(cur.pm / g.pmb) * g.bstep;
    S.a_ready(cur);
    if constexpr (SP2) {
        PG8_STAGE(PG8_SB(0, 0), cB, voffB); PG8_STAGE(PG8_SB(0, 1), cB + hstep, voffB); PG8_STAGE(PG8_SA(0, 0), cA, voffA); PG8_STAGE(PG8_SA(0, 1), cA + hstep, voffA);
        if (wr == 1) PG8_BAR;
        PG8_WAIT_V(2); PG8_BAR;
        PG8_STAGE(PG8_SB(1, 0), cB + kstep, voffB); PG8_STAGE(PG8_SA(1, 0), cA + kstep, voffA); PG8_STAGE(PG8_SB(1, 1), cB + hstep + kstep, voffB);
        PG8_WAIT_V(6); PG8_BAR;
    } else {
        PG8_STAGE(PG8_SB(0, 0), cB, voffB); PG8_STAGE(PG8_SA(0, 0), cA, voffA); PG8_STAGE(PG8_SB(0, 1), cB + hstep, voffB); PG8_STAGE(PG8_SA(0, 1), cA + hstep, voffA);
        if (wr == 1) PG8_BAR;
        PG8_WAIT_V(4); PG8_BAR;
        PG8_STAGE(PG8_SB(1, 0), cB + kstep, voffB); PG8_STAGE(PG8_SA(1, 0), cA + kstep, voffA); PG8_STAGE(PG8_SB(1, 1), cB + hstep + kstep, voffB);
        PG8_WAIT_V(6); PG8_BAR;
    }
    for (;;) {
        const bool has_next = S.next(ui + 1, nxt);
        const char* nA = has_next ? (const char*)g.A + (size_t)nxt.pm * tstep : cA; const char* nB = has_next ? (const char*)g.Bt + (size_t)nxt.pn * tstep + (size_t)(nxt.pm / g.pmb) * g.bstep : cB;
        for (int t = 0; t < nt; t += 2) {
            const bool last = (t == nt - 2);
            const char* a1 = cA + (size_t)(t + 1) * kstep;
            const char* a2 = last ? nA : cA + (size_t)(t + 2) * kstep; const char* b2 = last ? nB : cB + (size_t)(t + 2) * kstep;
            const char* a3 = a2 + kstep; const char* b3 = b2 + kstep;
            if (last && has_next) S.a_ready(nxt);
            if constexpr (SP2) {
            PG8_LDB(B0, 0, 0); PG8_LDB(B1, 0, 1); PG8_SCHED; PG8_LDA(At, 0, 0); PG8_STAGE(PG8_SA(1, 1), a1 + hstep, voffA);
            PG8_WAIT_V(8); PG8_WAIT_L(0); PG8_BAR; PG8_MMA(0, 0, At, B0); PG8_MMA(0, 1, At, B1); PG8_BAR; PG8_SCHED;
            PG8_LDA(At, 0, 1); PG8_STAGE(PG8_SB(0, 0), b2, voffB); PG8_STAGE(PG8_SB(0, 1), b2 + hstep, voffB); PG8_STAGE(PG8_SA(0, 0), a2, voffA);
            PG8_WAIT_V(8); PG8_WAIT_L(0); PG8_BAR; PG8_MMA(1, 0, At, B0); PG8_MMA(1, 1, At, B1); PG8_BAR; PG8_SCHED;
            PG8_LDB(B0, 1, 0); PG8_LDB(B1, 1, 1); PG8_SCHED; PG8_LDA(At, 1, 0); PG8_STAGE(PG8_SA(0, 1), a2 + hstep, voffA);
            PG8_WAIT_V(8); PG8_WAIT_L(0); PG8_BAR; PG8_MMA(0, 0, At, B0); PG8_MMA(0, 1, At, B1); PG8_BAR; PG8_SCHED;
            PG8_LDA(At, 1, 1); PG8_STAGE(PG8_SB(1, 0), b3, voffB); PG8_STAGE(PG8_SB(1, 1), b3 + hstep, voffB); PG8_STAGE(PG8_SA(1, 0), a3, voffA);
            PG8_WAIT_V(8); PG8_WAIT_L(0); PG8_BAR; PG8_MMA(1, 0, At, B0); PG8_MMA(1, 1, At, B1); PG8_BAR; PG8_SCHED;
            } else {
            PG8_LDB(B0, 0, 0); PG8_SCHED; PG8_LDA(At, 0, 0); PG8_STAGE(PG8_SA(1, 1), a1 + hstep, voffA);
            PG8_WAIT_L(8); PG8_BAR; PG8_WAIT_L(0); PG8_MMA(0, 0, At, B0); PG8_BAR; PG8_SCHED;
            PG8_LDB(B1, 0, 1); PG8_STAGE(PG8_SB(0, 0), b2, voffB);
            PG8_BAR; PG8_WAIT_L(0); PG8_MMA(0, 1, At, B1); PG8_BAR;
            PG8_LDA(At, 0, 1); PG8_STAGE(PG8_SA(0, 0), a2, voffA);
            PG8_BAR; PG8_WAIT_L(0); PG8_MMA(1, 0, At, B0); PG8_BAR; PG8_SCHED;
            PG8_STAGE(PG8_SB(0, 1), b2 + hstep, voffB);
            PG8_WAIT_V(6); PG8_BAR; PG8_MMA(1, 1, At, B1); PG8_BAR;
            PG8_LDB(B0, 1, 0); PG8_SCHED; PG8_LDA(At, 1, 0); PG8_STAGE(PG8_SA(0, 1), a2 + hstep, voffA);
            PG8_WAIT_L(8); PG8_BAR; PG8_WAIT_L(0); PG8_MMA(0, 0, At, B0); PG8_BAR; PG8_SCHED;
            PG8_LDB(B1, 1, 1); PG8_STAGE(PG8_SB(1, 0), b3, voffB);
            PG8_BAR; PG8_WAIT_L(0); PG8_MMA(0, 1, At, B1); PG8_BAR;
            PG8_LDA(At, 1, 1); PG8_STAGE(PG8_SA(1, 0), a3, voffA);
            PG8_BAR; PG8_WAIT_L(0); PG8_MMA(1, 0, At, B0); PG8_BAR; PG8_SCHED;
            PG8_STAGE(PG8_SB(1, 1), b3 + hstep, voffB);
            PG8_WAIT_V(6); PG8_BAR; PG8_MMA(1, 1, At, B1); PG8_BAR;
            }
        }
        if constexpr (ALIGN_EPI) { if (wr == 0) PG8_BAR; }
        if constexpr (!Epi::AFTER_DRAIN) { E(acc, cur, wr, wc, fr, fq); S.done(cur); }
        if (!has_next) break;
#pragma unroll
        for (int a = 0; a < 2; ++a)
#pragma unroll
            for (int b = 0; b < 2; ++b)
#pragma unroll
                for (int m = 0; m < 4; ++m)
#pragma unroll
                    for (int n = 0; n < 2; ++n) acc[a][b][m][n] = (AccT){0, 0, 0, 0};
        cur = nxt; cA = nA; cB = nB; ++ui;
        if constexpr (ALIGN_EPI) { if (wr == 1) PG8_BAR; }
    }
    PG8_WAIT_V(0);
    if constexpr (!ALIGN_EPI) { if (wr == 0) PG8_BAR; }
    PG8_BAR;
    if constexpr (Epi::AFTER_DRAIN) { E.fused(acc, cur, wr, wc, fr, fq, lds, wid, lane); S.done(cur); }
#undef PG8_SA
#undef PG8_SB
#undef PG8_STAGE
#undef PG8_LDA
#undef PG8_LDB
#undef PG8_MMA
#undef PG8_WAIT_V
#undef PG8_WAIT_L
#undef PG8_BAR
#undef PG8_SCHED
}
typedef __bf16 bf16x2_t __attribute__((ext_vector_type(2))); typedef float f32x2 __attribute__((ext_vector_type(2)));
__device__ __forceinline__ unsigned pk2(float lo, float hi) { f32x2 v = {lo, hi}; bf16x2_t b = __builtin_convertvector(v, bf16x2_t); return __builtin_bit_cast(unsigned, b); }
__device__ __forceinline__ float silu_f(float v) { return v * __builtin_amdgcn_rcpf(1.0f + __expf(-v)); }
template <bool FUSED> struct EpiSwiGLU {
    static constexpr bool PERM = true, AFTER_DRAIN = false;
    bf16_t* O; const float* rssq; const float* sW; int ldc; int sw_bstride; int rows_per_batch;
    __device__ __forceinline__ void operator()(const f32x4 (&acc)[2][2][4][2], const Unit& u, int wr, int wc, int fr, int fq) const {
        const int row0 = u.pm * BM + wr * 64 + fr, col0 = u.pn * HALF + wc * 32 + 8 * fq;
        f32x4 sg[2], su[2];
        if (FUSED) { const float* sp = sW + (size_t)((u.pm * BM) / rows_per_batch) * sw_bstride + u.pn * BM + wc * 32 + 8 * fq;
            sg[0] = *(const f32x4*)sp; sg[1] = *(const f32x4*)(sp + 4); su[0] = *(const f32x4*)(sp + HALF); su[1] = *(const f32x4*)(sp + HALF + 4); }
#pragma unroll
        for (int ai = 0; ai < 2; ++ai)
#pragma unroll
            for (int m = 0; m < 4; ++m) { bf16_t* rowp = O + (size_t)(row0 + ai * HALF + m * 16) * ldc + col0;
                f32x4 g0 = acc[ai][0][m][0], g1 = acc[ai][0][m][1], u0 = acc[ai][1][m][0], u1 = acc[ai][1][m][1];
                if (FUSED) { const float rs = rsqrtf(rssq[row0 + ai * HALF + m * 16] * (1.f / 1024.f) + 1e-6f); g0 = g0 * rs + sg[0]; g1 = g1 * rs + sg[1]; u0 = u0 * rs + su[0]; u1 = u1 * rs + su[1]; }
                u32x4 w; w.x = pk2(silu_f(g0[0]) * u0[0], silu_f(g0[1]) * u0[1]); w.y = pk2(silu_f(g0[2]) * u0[2], silu_f(g0[3]) * u0[3]);
                w.z = pk2(silu_f(g1[0]) * u1[0], silu_f(g1[1]) * u1[1]); w.w = pk2(silu_f(g1[2]) * u1[2], silu_f(g1[3]) * u1[3]);
                *(u32x4*)rowp = w; }
    }
};
struct EpiSwiGLUq {
    static constexpr bool PERM = true, AFTER_DRAIN = false;
    bf16_t* O; const float* rowscale; const float* colscale; int ldc;
    __device__ __forceinline__ void operator()(const i32x4 (&acc)[2][2][4][2], const Unit& u, int wr, int wc, int fr, int fq) const {
        const int row0 = u.pm * BM + wr * 64 + fr, col0 = u.pn * HALF + wc * 32 + 8 * fq;
        const float* sp = colscale + u.pn * BM + wc * 32 + 8 * fq;
        const f32x4 sg0 = *(const f32x4*)sp, sg1 = *(const f32x4*)(sp + 4), su0 = *(const f32x4*)(sp + HALF), su1 = *(const f32x4*)(sp + HALF + 4);
#pragma unroll
        for (int ai = 0; ai < 2; ++ai)
#pragma unroll
            for (int m = 0; m < 4; ++m) { bf16_t* rowp = O + (size_t)(row0 + ai * HALF + m * 16) * ldc + col0;
                const float rs = rowscale[row0 + ai * HALF + m * 16];
                const f32x4 g0 = __builtin_convertvector(acc[ai][0][m][0], f32x4) * (sg0 * rs), g1 = __builtin_convertvector(acc[ai][0][m][1], f32x4) * (sg1 * rs);
                const f32x4 u0 = __builtin_convertvector(acc[ai][1][m][0], f32x4) * (su0 * rs), u1 = __builtin_convertvector(acc[ai][1][m][1], f32x4) * (su1 * rs);
                u32x4 w; w.x = pk2(silu_f(g0[0]) * u0[0], silu_f(g0[1]) * u0[1]); w.y = pk2(silu_f(g0[2]) * u0[2], silu_f(g0[3]) * u0[3]);
                w.z = pk2(silu_f(g1[0]) * u1[0], silu_f(g1[1]) * u1[1]); w.w = pk2(silu_f(g1[2]) * u1[2], silu_f(g1[3]) * u1[3]);
                *(u32x4*)rowp = w; }
    }
};
template <bool BASE_BF16, bool OUT_BF16, bool RS = false, bool SSQ = false> struct EpiResid {
    static constexpr bool PERM = true, AFTER_DRAIN = false;
    const void* base; void* out; const float* gate; const float* rssq; float* ossq; int ldc; int gate_bstride; int rows_per_batch; float coef; float rs_inv_n;
    __device__ __forceinline__ void operator()(const f32x4 (&acc)[2][2][4][2], const Unit& u, int wr, int wc, int fr, int fq) const {
        const int row0 = u.pm * BM + wr * 64 + fr, col0 = u.pn * BM + wc * 32 + 8 * fq;
        const float* gp = gate + (size_t)((u.pm * BM) / rows_per_batch) * gate_bstride + col0;
        f32x4 gv[2][2];
#pragma unroll
        for (int bj = 0; bj < 2; ++bj)
#pragma unroll
            for (int n = 0; n < 2; ++n) gv[bj][n] = (*(const f32x4*)(gp + bj * HALF + n * 4) + 1.0f) * coef;
        constexpr int GB = BASE_BF16 ? 4 : 2;
#pragma unroll
        for (int gb = 0; gb < 8; gb += GB) {
            u32x4 braw[GB][2][BASE_BF16 ? 1 : 2];
#pragma unroll
            for (int q = 0; q < GB; ++q) { const int ai = (gb + q) >> 2, m = (gb + q) & 3; const size_t off = (size_t)(row0 + ai * HALF + m * 16) * ldc + col0;
#pragma unroll
                for (int bj = 0; bj < 2; ++bj) {
                    if (BASE_BF16) braw[q][bj][0] = *(const u32x4*)((const bf16_t*)base + off + bj * HALF);
                    else { braw[q][bj][0] = *(const u32x4*)((const float*)base + off + bj * HALF); braw[q][bj][BASE_BF16 ? 0 : 1] = *(const u32x4*)((const float*)base + off + bj * HALF + 4); } } }
#pragma unroll
            for (int q = 0; q < GB; ++q) { const int ai = (gb + q) >> 2, m = (gb + q) & 3; const size_t off = (size_t)(row0 + ai * HALF + m * 16) * ldc + col0;
                float rsc = 1.0f; if (RS) rsc = rsqrtf(rssq[row0 + ai * HALF + m * 16] * rs_inv_n + 1e-6f);
                float sq = 0.f;
#pragma unroll
                for (int bj = 0; bj < 2; ++bj) {
                    f32x4 b0, b1;
                    if (BASE_BF16) { const u32x4 w = braw[q][bj][0];
                        b0 = (f32x4){__uint_as_float(w.x << 16), __uint_as_float(w.x & 0xffff0000u), __uint_as_float(w.y << 16), __uint_as_float(w.y & 0xffff0000u)};
                        b1 = (f32x4){__uint_as_float(w.z << 16), __uint_as_float(w.z & 0xffff0000u), __uint_as_float(w.w << 16), __uint_as_float(w.w & 0xffff0000u)}; }
                    else { b0 = __builtin_bit_cast(f32x4, braw[q][bj][0]); b1 = __builtin_bit_cast(f32x4, braw[q][bj][BASE_BF16 ? 0 : 1]); }
                    f32x4 a0 = acc[ai][bj][m][0], a1 = acc[ai][bj][m][1]; if (RS) { a0 = a0 * rsc; a1 = a1 * rsc; }
                    const f32x4 o0 = b0 + a0 * gv[bj][0], o1 = b1 + a1 * gv[bj][1];
                    if (SSQ) sq += (o0[0] * o0[0] + o0[1] * o0[1]) + (o0[2] * o0[2] + o0[3] * o0[3]) + (o1[0] * o1[0] + o1[1] * o1[1]) + (o1[2] * o1[2] + o1[3] * o1[3]);
                    if (OUT_BF16) { u32x4 w; w.x = pk2(o0[0], o0[1]); w.y = pk2(o0[2], o0[3]); w.z = pk2(o1[0], o1[1]); w.w = pk2(o1[2], o1[3]); *(u32x4*)((bf16_t*)out + off + bj * HALF) = w; }
                    else { *(f32x4*)((float*)out + off + bj * HALF) = o0; *(f32x4*)((float*)out + off + bj * HALF + 4) = o1; }
                }
                if (SSQ) { sq += __shfl_xor(sq, 16); sq += __shfl_xor(sq, 32); if (fq == 0) __hip_atomic_fetch_add(ossq + row0 + ai * HALF + m * 16, sq, __ATOMIC_RELAXED, __HIP_MEMORY_SCOPE_AGENT); }
            }
            asm volatile("" ::: "memory");
        }
    }
};
struct EpiProj {
    static constexpr bool PERM = true, AFTER_DRAIN = false;
    bf16_t* O; float* DT; const float* dt_bias; const float* rssq; const float* sW; int ldc; int nfull; int sw_bstride; int rows_per_batch;
    __device__ __forceinline__ void operator()(const f32x4 (&acc)[2][2][4][2], const Unit& u, int wr, int wc, int fr, int fq) const {
        const int row0 = u.pm * BM + wr * 64 + fr;
        const float* sp = sW + (size_t)((u.pm * BM) / rows_per_batch) * sw_bstride + u.pn * BM + wc * 32 + 8 * fq;
        if (u.pn < nfull) {
            const int col0 = u.pn * BM + wc * 32 + 8 * fq;
            f32x4 sv[2][2];
#pragma unroll
            for (int bj = 0; bj < 2; ++bj) { sv[bj][0] = *(const f32x4*)(sp + bj * HALF); sv[bj][1] = *(const f32x4*)(sp + bj * HALF + 4); }
#pragma unroll
            for (int ai = 0; ai < 2; ++ai)
#pragma unroll
                for (int m = 0; m < 4; ++m) { bf16_t* rowp = O + (size_t)(row0 + ai * HALF + m * 16) * ldc + col0;
                    const float rs = rsqrtf(rssq[row0 + ai * HALF + m * 16] * (1.f / 1024.f) + 1e-6f);
#pragma unroll
                    for (int bj = 0; bj < 2; ++bj) { const f32x4 v0 = acc[ai][bj][m][0] * rs + sv[bj][0], v1 = acc[ai][bj][m][1] * rs + sv[bj][1];
                        u32x4 w; w.x = pk2(v0[0], v0[1]); w.y = pk2(v0[2], v0[3]); w.z = pk2(v1[0], v1[1]); w.w = pk2(v1[2], v1[3]);
                        *(u32x4*)(rowp + bj * HALF) = w; } }
        } else if (wc == 0 && fq < 2) {
            const f32x4 b0 = *(const f32x4*)(dt_bias + 8 * fq) + *(const f32x4*)sp, b1 = *(const f32x4*)(dt_bias + 8 * fq + 4) + *(const f32x4*)(sp + 4);
#pragma unroll
            for (int ai = 0; ai < 2; ++ai)
#pragma unroll
                for (int m = 0; m < 4; ++m) { float* rowp = DT + (size_t)(row0 + ai * HALF + m * 16) * 16 + 8 * fq;
                    const float rs = rsqrtf(rssq[row0 + ai * HALF + m * 16] * (1.f / 1024.f) + 1e-6f);
                    f32x4 v0 = acc[ai][0][m][0] * rs + b0, v1 = acc[ai][0][m][1] * rs + b1;
#pragma unroll
                    for (int j = 0; j < 4; ++j) { v0[j] = v0[j] > 20.f ? v0[j] : log1pf(__expf(v0[j])); v1[j] = v1[j] > 20.f ? v1[j] : log1pf(__expf(v1[j])); }
                    *(f32x4*)rowp = v0; *(f32x4*)(rowp + 4) = v1; }
        }
    }
};
struct EpiNull { static constexpr bool PERM = true, AFTER_DRAIN = false; float* sink;
    __device__ __forceinline__ void operator()(const f32x4 (&acc)[2][2][4][2], const Unit& u, int wr, int wc, int fr, int fq) const {
        f32x4 s = {0.f, 0.f, 0.f, 0.f};
#pragma unroll
        for (int ai = 0; ai < 2; ++ai)
#pragma unroll
            for (int bj = 0; bj < 2; ++bj)
#pragma unroll
                for (int m = 0; m < 4; ++m)
#pragma unroll
                    for (int n = 0; n < 2; ++n) s += acc[ai][bj][m][n];
        if (s[0] + s[1] + s[2] + s[3] == 123.456f) sink[0] = s[0]; }
};
}
#define GAS __attribute__((address_space(1)))
#define LAS __attribute__((address_space(3)))
typedef unsigned short bf16;
typedef unsigned v4u __attribute__((ext_vector_type(4)));
typedef unsigned v2u __attribute__((ext_vector_type(2)));
typedef float f32x4 __attribute__((ext_vector_type(4)));
typedef float f32x16 __attribute__((ext_vector_type(16)));
typedef short bf16x8 __attribute__((ext_vector_type(8)));
typedef short s16x4 __attribute__((ext_vector_type(4)));
typedef short v4i16_t __attribute__((ext_vector_type(4)));
using pg8::pk2; using pg8::silu_f;

constexpr int NWAVES = 8, NTHR = 512;
constexpr int D = 1024, BATCH = 4, SEQ = 8192, M = BATCH * SEQ;
constexpr int DFF = 2816, NGU = 2 * DFF;
constexpr int NPROJ = 2304, NPROJ_PAD = 2560, IN_WIDTH = 2320;
constexpr int PZ = 0, PXBC = 512, PQ = 1536, PK = 2048, PV = 2176;
constexpr int NCHUNK = 64, CH = 128;
constexpr int NMOD = 9 * D;
constexpr float EPS = 1e-6f;
constexpr float LOG2E = 1.4426950408889634f;
constexpr float QSCALE = 0.125f * LOG2E;

constexpr size_t MiB = 1u << 20;
constexpr size_t WS_CTL = 0, CTL_ZERO_BYTES = 1 * MiB;
constexpr size_t CTL_MOD = 65536, CTL_BAR = 16384, CTL_SSQ = 262144, CTL_RSSQ1 = 393216, CTL_RSSQ2 = 524288, CTL_SW2 = 655360, CTL_SW3 = 720896;
constexpr size_t CTL_ROWSC = 720896, CTL_CMAX = 860160, CTL_COLSC = 917504;
constexpr size_t WS_WGU1 = 2 * MiB, WS_WD1 = 13 * MiB, WS_WIN = 19 * MiB, WS_WOUT = 24 * MiB, WS_WGU2 = 26 * MiB, WS_WD2 = 37 * MiB;
constexpr size_t WS_DT = 43 * MiB, WS_CD = 45 * MiB;
constexpr size_t WS_U = 48 * MiB;
constexpr size_t WS_H = 112 * MiB;
constexpr size_t WS_WINB = 288 * MiB;
constexpr size_t WS_WGU2B = 308 * MiB;
constexpr size_t WS_X1 = 416 * MiB;
constexpr size_t WS_END = 480 * MiB;

constexpr int XS_PITCH = 528, BS_PITCH = 272, KV_PITCH = 144;
constexpr int L_XS = 0, L_BS = 128 * XS_PITCH, L_CS = L_BS + 128 * BS_PITCH, L_ARR = L_CS + 128 * BS_PITCH, L_END = L_ARR + 8192;
constexpr int LDS_BYTES = 152 * 1024;
static_assert(L_END + 64 <= LDS_BYTES && pg8::STAGE_BYTES <= LDS_BYTES, "LDS map");

struct Frame { LAS unsigned char* lds; int tid, lane, wave, vcu, G; };

__device__ __forceinline__ float bf_lo(unsigned w) { return __uint_as_float(w << 16); }
__device__ __forceinline__ float bf_hi(unsigned w) { return __uint_as_float(w & 0xffff0000u); }
__device__ __forceinline__ float wave_sum(float v) {
#pragma unroll
    for (int o = 1; o < 64; o <<= 1) v += __shfl_xor(v, o);
    return v;
}
#define LDS_WAIT() asm volatile("s_waitcnt lgkmcnt(0)" ::: "memory")
__device__ __forceinline__ f32x16 mfma32(bf16x8 a, bf16x8 b, f32x16 c) { return __builtin_amdgcn_mfma_f32_32x32x16_bf16(a, b, c, 0, 0, 0); }
__device__ __forceinline__ int crow(int reg, int h) { return (reg & 3) + 8 * (reg >> 2) + 4 * h; }
__device__ __forceinline__ bf16x8 frag_row(const LAS unsigned char* base, int pitch, int mn0, int k0, int lane) {
    return *(const LAS bf16x8*)(base + (mn0 + (lane & 31)) * pitch + (k0 + 8 * (lane >> 5)) * 2);
}
__device__ __forceinline__ s16x4 ds_tr(const LAS unsigned char* p) { return __builtin_bit_cast(s16x4, __builtin_amdgcn_ds_read_tr16_b64_v4i16((LAS v4i16_t*)p)); }
__device__ __forceinline__ bf16x8 frag_tr(const LAS unsigned char* base, int pitch, int kA, int kB, int mn0, int lane) {
    const int q4 = (lane & 15) >> 2, cb = (mn0 + 16 * ((lane >> 4) & 1) + 4 * (lane & 3)) * 2;
    const s16x4 a = ds_tr(base + (kA + q4) * pitch + cb), b = ds_tr(base + (kB + q4) * pitch + cb);
    bf16x8 r; r[0] = a[0]; r[1] = a[1]; r[2] = a[2]; r[3] = a[3]; r[4] = b[0]; r[5] = b[1]; r[6] = b[2]; r[7] = b[3]; return r;
}
__device__ __forceinline__ int perm_row(int m, int t) { return 32 * ((m >> 2) & 1) + 16 * t + 4 * (m >> 3) + (m & 3); }
__device__ __forceinline__ bf16x8 frag_tr_perm(const LAS unsigned char* base, int pitch, int kA, int kB, int mn_base, int t, int lane) {
    const int q4 = (lane & 15) >> 2, cb = (mn_base + 32 * (lane & 1) + 16 * t + 8 * ((lane >> 4) & 1) + 4 * ((lane >> 1) & 1)) * 2;
    const s16x4 a = ds_tr(base + (kA + q4) * pitch + cb), b2 = ds_tr(base + (kB + q4) * pitch + cb);
    bf16x8 r; r[0] = a[0]; r[1] = a[1]; r[2] = a[2]; r[3] = a[3]; r[4] = b2[0]; r[5] = b2[1]; r[6] = b2[2]; r[7] = b2[3]; return r;
}
__device__ __forceinline__ bf16x8 pack_step(const f32x16& x, int s) {
    v4u p; p.x = pk2(x[8 * s], x[8 * s + 1]); p.y = pk2(x[8 * s + 2], x[8 * s + 3]); p.z = pk2(x[8 * s + 4], x[8 * s + 5]); p.w = pk2(x[8 * s + 6], x[8 * s + 7]);
    return __builtin_bit_cast(bf16x8, p);
}

template <int MAP> __device__ __forceinline__ int map_row(int n) {
    if (MAP == 1) return 256 * (n >> 7) + (n & 127);
    if (MAP == 2) return 256 * (n >> 7) + 128 + (n & 127);
    if (MAP == 3) { if (n < 1536) return n; if (n < 1552) return NPROJ + (n - 1536); return n - 16; }
    return n;
}
template <int MAP>
__device__ __forceinline__ void transpose_item(const float* W, int K, int N, bf16* WT, LAS float* scr, int item, int lane) {
    const int nblk = (N + 31) / 32, kb = item / nblk, nb = item % nblk, k0 = 64 * kb, n0 = 32 * nb;
    const int nn = n0 + (lane & 31);
#pragma unroll
    for (int i = 0; i < 32; ++i) { const int kk = 2 * i + (lane >> 5); scr[kk * 33 + (lane & 31)] = nn < N ? W[(size_t)(k0 + kk) * N + nn] : 0.f; }
    LDS_WAIT(); asm volatile("" ::: "memory");
    const int c = lane & 7;
#pragma unroll
    for (int j = 0; j < 4; ++j) { const int n = (lane >> 3) + 8 * j; const LAS float* s = scr + (8 * c) * 33 + n;
        v4u o; o.x = pk2(s[0 * 33], s[1 * 33]); o.y = pk2(s[2 * 33], s[3 * 33]); o.z = pk2(s[4 * 33], s[5 * 33]); o.w = pk2(s[6 * 33], s[7 * 33]);
        if (n0 + n < N) *(v4u*)(WT + (size_t)map_row<MAP>(n0 + n) * K + k0 + 8 * c) = o; }
    LDS_WAIT(); asm volatile("" ::: "memory");
}
struct P0Args { const float *wg1, *wu1, *wd1, *wout, *wd2, *c, *wada, *bada, *wg2, *wu2; bf16 *WGU1, *WD1, *WOUT, *WD2; float* mod; unsigned* cmax; };
__device__ __forceinline__ void p0_prologue(const Frame& F, const P0Args& A) {
    LAS float* scr = (LAS float*)(F.lds + F.wave * 16384);
    const int gw = F.vcu * NWAVES + F.wave, NGW = F.G * NWAVES;
    constexpr int I_D = (DFF / 64) * (D / 32), I_O = (D / 64) * (D / 32);
    constexpr int NITEMS = 2 * I_D + I_O;
    for (int it = gw; it < NITEMS; it += NGW) {
        int r = it;
        if (r < I_D)  { transpose_item<0>(A.wd1, DFF, D, A.WD1, scr, r, F.lane); continue; } r -= I_D;
        if (r < I_D)  { transpose_item<0>(A.wd2, DFF, D, A.WD2, scr, r, F.lane); continue; } r -= I_D;
        transpose_item<0>(A.wout, D, D, A.WOUT, scr, r, F.lane);
    }
    { constexpr int NCGW = DFF / 64, NKSW = D / 64;
      for (int it = gw; it < 4 * NCGW * NKSW; it += NGW) {
          const int mat = it / (NCGW * NKSW), rr = it % (NCGW * NKSW), cgp = rr % NCGW, ks = rr / NCGW, n = cgp * 64 + F.lane;
          const float* W = mat == 0 ? A.wg1 : mat == 1 ? A.wu1 : mat == 2 ? A.wg2 : A.wu2;
          const float* wp = W + (size_t)(ks * 64) * DFF + n;
          float mx = 0.f;
#pragma unroll 32
          for (int kk = 0; kk < 64; ++kk) mx = fmaxf(mx, fabsf(wp[(size_t)kk * DFF]));
          const int prow = (mat & 1) ? map_row<2>(n) : map_row<1>(n);
          atomicMax(A.cmax + (mat >> 1) * NGU + prow, __float_as_uint(mx)); } }
    constexpr int NCG = NMOD / 64, NKS = D / 64;
    for (int it = gw; it < NCG * NKS; it += NGW) {
        const int cgp = it % NCG, ks = it / NCG, n = cgp * 64 + F.lane, k0 = ks * 64;
        float s[4], acc[4] = {0.f, 0.f, 0.f, 0.f};
#pragma unroll
        for (int b = 0; b < 4; ++b) s[b] = silu_f(A.c[b * D + k0 + F.lane]);
        const float* wp = A.wada + (size_t)k0 * NMOD + n;
#pragma unroll 32
        for (int kk = 0; kk < 64; ++kk) { const float w = wp[(size_t)kk * NMOD];
#pragma unroll
            for (int b = 0; b < 4; ++b) acc[b] += w * __uint_as_float(__builtin_amdgcn_readlane(__float_as_uint(s[b]), kk)); }
        const float bias = ks == 0 ? A.bada[n] : 0.f;
#pragma unroll
        for (int b = 0; b < 4; ++b) __hip_atomic_fetch_add(A.mod + b * NMOD + n, acc[b] + bias, __ATOMIC_RELAXED, __HIP_MEMORY_SCOPE_AGENT);
    }
}

template <int MAP>
__device__ __forceinline__ void quant_item(const float* W, int K, int N, signed char* WQ, const unsigned* cmax, float* colscale, LAS float* scr, int item, int lane) {
    const int nblk = (N + 31) / 32, kb = item / nblk, nb = item % nblk, k0 = 64 * kb, n0 = 32 * nb;
    const int nn = n0 + (lane & 31);
#pragma unroll
    for (int i = 0; i < 32; ++i) { const int kk = 2 * i + (lane >> 5); scr[kk * 33 + (lane & 31)] = nn < N ? W[(size_t)(k0 + kk) * N + nn] : 0.f; }
    LDS_WAIT(); asm volatile("" ::: "memory");
    const int c = lane & 7;
#pragma unroll
    for (int j = 0; j < 4; ++j) { const int n = (lane >> 3) + 8 * j; const LAS float* s = scr + (8 * c) * 33 + n;
        const int prow = map_row<MAP>(n0 + n);
        const float cm = fmaxf(__uint_as_float(cmax[prow]), 1e-30f), inv = 127.0f / cm;
        unsigned lo = 0u, hi = 0u;
#pragma unroll
        for (int jj = 0; jj < 4; ++jj) { lo |= ((unsigned)((int)rintf(s[jj * 33] * inv)) & 0xffu) << (8 * jj); hi |= ((unsigned)((int)rintf(s[(jj + 4) * 33] * inv)) & 0xffu) << (8 * jj); }
        v2u o; o.x = lo; o.y = hi;
        if (n0 + n < N) { *(v2u*)(WQ + (size_t)prow * K + k0 + 8 * c) = o; if (kb == 0 && c == 0) colscale[prow] = cm * (1.0f / 127.0f); } }
    LDS_WAIT(); asm volatile("" ::: "memory");
}

template <int MAP>
__device__ __forceinline__ void scale_item(const float* W, int K, int N, bf16* WB, size_t copy_stride, const float* gain, const float* mod, int i_shift, int i_scale, float* sW, int sw_stride, LAS float* scr, int item, int lane) {
    const int nblk = (N + 31) / 32, kb = item / nblk, nb = item % nblk, k0 = 64 * kb, n0 = 32 * nb;
    const int nn = n0 + (lane & 31);
#pragma unroll
    for (int i = 0; i < 32; ++i) { const int kk = 2 * i + (lane >> 5); scr[kk * 33 + (lane & 31)] = nn < N ? W[(size_t)(k0 + kk) * N + nn] : 0.f; }
    float gsv[4], shv[4];
    { const float gn = gain[k0 + lane];
#pragma unroll
      for (int b = 0; b < 4; ++b) { gsv[b] = gn * (1.0f + mod[b * NMOD + i_scale * D + k0 + lane]); shv[b] = mod[b * NMOD + i_shift * D + k0 + lane]; } }
    LDS_WAIT(); asm volatile("" ::: "memory");
    { float acc[4] = {0.f, 0.f, 0.f, 0.f};
#pragma unroll 16
      for (int kk = 0; kk < 64; ++kk) { const float w = scr[kk * 33 + (lane & 31)];
#pragma unroll
          for (int b = 0; b < 4; ++b) acc[b] += w * __uint_as_float(__builtin_amdgcn_readlane(__float_as_uint(shv[b]), kk)); }
      if (lane < 32 && nn < N) {
#pragma unroll
          for (int b = 0; b < 4; ++b) __hip_atomic_fetch_add(sW + b * sw_stride + map_row<MAP>(nn), acc[b], __ATOMIC_RELAXED, __HIP_MEMORY_SCOPE_AGENT); } }
    const int c = lane & 7;
#pragma unroll
    for (int b = 0; b < 4; ++b) {
        float gk[8];
#pragma unroll
        for (int jj = 0; jj < 8; ++jj) gk[jj] = __shfl(gsv[b], 8 * c + jj);
#pragma unroll
        for (int j = 0; j < 4; ++j) { const int n = (lane >> 3) + 8 * j; const LAS float* s = scr + (8 * c) * 33 + n;
            v4u o; o.x = pk2(s[0 * 33] * gk[0], s[1 * 33] * gk[1]); o.y = pk2(s[2 * 33] * gk[2], s[3 * 33] * gk[3]); o.z = pk2(s[4 * 33] * gk[4], s[5 * 33] * gk[5]); o.w = pk2(s[6 * 33] * gk[6], s[7 * 33] * gk[7]);
            if (n0 + n < N) *(v4u*)(WB + b * copy_stride + (size_t)map_row<MAP>(n0 + n) * K + k0 + 8 * c) = o; }
    }
    LDS_WAIT(); asm volatile("" ::: "memory");
}
struct PrepArgs { const float *win, *wg1, *wu1, *wg2, *wu2, *gain2, *mod; bf16* WINB; float* sW2; signed char *WGU1Q, *WGU2Q; const unsigned* cmax; float* colscale; };
__device__ __forceinline__ void prep_phase(const Frame& F, const PrepArgs& A) {
    LAS float* scr = (LAS float*)(F.lds + F.wave * 16384);
    const int gw = F.vcu * NWAVES + F.wave, NGW = F.G * NWAVES;
    constexpr int I_GU = (D / 64) * (DFF / 32), I_IN = (D / 64) * ((IN_WIDTH + 31) / 32);
    for (int it = gw; it < 4 * I_GU + I_IN; it += NGW) {
        int r = it;
        if (r < I_IN) { scale_item<3>(A.win, D, IN_WIDTH, A.WINB, (size_t)NPROJ_PAD * D, A.gain2, A.mod, 3, 4, A.sW2, NPROJ_PAD, scr, r, F.lane); continue; } r -= I_IN;
        if (r < I_GU) { quant_item<1>(A.wg1, D, DFF, A.WGU1Q, A.cmax, A.colscale, scr, r, F.lane); continue; } r -= I_GU;
        if (r < I_GU) { quant_item<2>(A.wu1, D, DFF, A.WGU1Q, A.cmax, A.colscale, scr, r, F.lane); continue; } r -= I_GU;
        if (r < I_GU) { quant_item<1>(A.wg2, D, DFF, A.WGU2Q, A.cmax + NGU, A.colscale + NGU, scr, r, F.lane); continue; } r -= I_GU;
        quant_item<2>(A.wu2, D, DFF, A.WGU2Q, A.cmax + NGU, A.colscale + NGU, scr, r, F.lane);
    }
    { const int gt = (F.vcu * NTHR + F.tid), NT = F.G * NTHR; v4u z = {0u, 0u, 0u, 0u}; constexpr int PER = (NPROJ_PAD - IN_WIDTH) * D / 8;
      for (int i = gt; i < 4 * PER; i += NT) { const int b = i / PER, j = i % PER; *(v4u*)(A.WINB + (size_t)b * NPROJ_PAD * D + (size_t)IN_WIDTH * D + (size_t)j * 8) = z; } }
}

template <bool IN_BF16>
__device__ __forceinline__ void norm_q_phase(const Frame& F, const void* xin_, const float* gain, const float* mod, int i_shift, int i_scale, signed char* Uq, float* rowscale) {
    const int gw = F.vcu * NWAVES + F.wave, NGW = F.G * NWAVES;
    for (int m0 = gw * 16; m0 < M; m0 += NGW * 16) {
        const int b = m0 / SEQ;
        f32x4 gs[4], sh[4];
#pragma unroll
        for (int j = 0; j < 4; ++j) { const int col = 4 * F.lane + 256 * j;
            const f32x4 g = *(const f32x4*)(gain + col), sc = *(const f32x4*)(mod + b * NMOD + i_scale * D + col);
            gs[j] = g * (sc + 1.0f); sh[j] = *(const f32x4*)(mod + b * NMOD + i_shift * D + col); }
        for (int r = 0; r < 16; ++r) {
            f32x4 v[4]; float s = 0.f;
            if (IN_BF16) { const v2u* xr = (const v2u*)((const bf16*)xin_ + (size_t)(m0 + r) * D) + F.lane;
#pragma unroll
                for (int j = 0; j < 4; ++j) { const v2u w = xr[64 * j]; v[j] = (f32x4){bf_lo(w.x), bf_hi(w.x), bf_lo(w.y), bf_hi(w.y)}; } }
            else { const f32x4* xr = (const f32x4*)((const float*)xin_ + (size_t)(m0 + r) * D) + F.lane;
#pragma unroll
                for (int j = 0; j < 4; ++j) v[j] = xr[64 * j]; }
#pragma unroll
            for (int j = 0; j < 4; ++j) s += (v[j].x * v[j].x + v[j].y * v[j].y) + (v[j].z * v[j].z + v[j].w * v[j].w);
            const float rstd = rsqrtf(wave_sum(s) * (1.f / D) + EPS);
            float mx = 0.f;
#pragma unroll
            for (int j = 0; j < 4; ++j) { v[j] = v[j] * rstd * gs[j] + sh[j]; mx = fmaxf(mx, fmaxf(fmaxf(fabsf(v[j].x), fabsf(v[j].y)), fmaxf(fabsf(v[j].z), fabsf(v[j].w)))); }
#pragma unroll
            for (int o = 1; o < 64; o <<= 1) mx = fmaxf(mx, __shfl_xor(mx, o));
            mx = fmaxf(mx, 1e-30f);
            const float inv = 127.0f / mx;
            unsigned* o4 = (unsigned*)(Uq + (size_t)(m0 + r) * D) + F.lane;
#pragma unroll
            for (int j = 0; j < 4; ++j) { const unsigned w = ((unsigned)((int)rintf(v[j].x * inv)) & 0xffu) | (((unsigned)((int)rintf(v[j].y * inv)) & 0xffu) << 8) | (((unsigned)((int)rintf(v[j].z * inv)) & 0xffu) << 16) | (((unsigned)((int)rintf(v[j].w * inv)) & 0xffu) << 24);
                o4[64 * j] = w; }
            if (F.lane == 0) rowscale[m0 + r] = mx * (1.0f / 127.0f);
        }
    }
}

template <bool IN_BF16>
__device__ __forceinline__ void norm_phase(const Frame& F, const void* xin_, const float* gain, const float* mod, int i_shift, int i_scale, bf16* U) {
    const int gw = F.vcu * NWAVES + F.wave, NGW = F.G * NWAVES;
    for (int m0 = gw * 16; m0 < M; m0 += NGW * 16) {
        const int b = m0 / SEQ;
        f32x4 gs[4], sh[4];
#pragma unroll
        for (int j = 0; j < 4; ++j) { const int col = 4 * F.lane + 256 * j;
            const f32x4 g = *(const f32x4*)(gain + col), sc = *(const f32x4*)(mod + b * NMOD + i_scale * D + col);
            gs[j] = g * (sc + 1.0f); sh[j] = *(const f32x4*)(mod + b * NMOD + i_shift * D + col); }
        for (int r = 0; r < 16; ++r) {
            f32x4 v[4]; float s = 0.f;
            if (IN_BF16) { const v2u* xr = (const v2u*)((const bf16*)xin_ + (size_t)(m0 + r) * D) + F.lane;
#pragma unroll
                for (int j = 0; j < 4; ++j) { const v2u w = xr[64 * j]; v[j] = (f32x4){bf_lo(w.x), bf_hi(w.x), bf_lo(w.y), bf_hi(w.y)}; } }
            else { const f32x4* xr = (const f32x4*)((const float*)xin_ + (size_t)(m0 + r) * D) + F.lane;
#pragma unroll
                for (int j = 0; j < 4; ++j) v[j] = xr[64 * j]; }
#pragma unroll
            for (int j = 0; j < 4; ++j) s += (v[j].x * v[j].x + v[j].y * v[j].y) + (v[j].z * v[j].z + v[j].w * v[j].w);
            const float rstd = rsqrtf(wave_sum(s) * (1.f / D) + EPS);
            v2u* o8 = (v2u*)(U + (size_t)(m0 + r) * D) + F.lane;
#pragma unroll
            for (int j = 0; j < 4; ++j) { const f32x4 o = v[j] * rstd * gs[j] + sh[j]; v2u w; w.x = pk2(o.x, o.y); w.y = pk2(o.z, o.w); o8[64 * j] = w; }
        }
    }
}
typedef GAS unsigned gu32;
#define RLX_AGENT __ATOMIC_RELAXED, __HIP_MEMORY_SCOPE_AGENT
#define XB_TMO      128
#define XB_XCNT(j)  (256  + 64 * (j))
#define XB_XSUB(j)  (1280 + 64 * (j))
#define XB_XGEN(j)  (2304 + 64 * (j))
#define XB_TOP      3328
#define XB_TOPGEN   3392
#define XCD_BAR_WORDS 3456
#define XB_SPIN_CAP (1u << 18)

__device__ __forceinline__ unsigned xb_ld(unsigned* p)              { return __hip_atomic_load(p, __ATOMIC_RELAXED, __HIP_MEMORY_SCOPE_AGENT); }
__device__ __forceinline__ unsigned xb_add(unsigned* p, unsigned v) { return __hip_atomic_fetch_add(p, v, __ATOMIC_RELAXED, __HIP_MEMORY_SCOPE_AGENT); }
__device__ __forceinline__ unsigned xb_xcc_id() { return (unsigned)__builtin_amdgcn_s_getreg((3 << 11) | 20) & 0xFu; }
#define XB_SPIN(cond, bar) do { unsigned _sp = 0; while (cond) { __builtin_amdgcn_s_sleep(1); \
    if ((++_sp & 255u) == 0u) { if (xb_ld(&(bar)[XB_TMO])) break; if (_sp > XB_SPIN_CAP) { atomicAdd(&(bar)[XB_TMO], 1u); break; } } } } while (0)

struct XcdBarrier {
    unsigned* bar; unsigned x;
    volatile LAS unsigned* st;
};

__device__ __forceinline__ XcdBarrier xcd_barrier_post(unsigned* bar, volatile LAS unsigned* st) {
    XcdBarrier b; b.bar = bar; b.x = xb_xcc_id(); b.st = st;
    if (threadIdx.x == 0) (void)xb_add(&bar[XB_XCNT(b.x)], 1u);
    return b;
}
__device__ __forceinline__ void xcd_barrier_complete(unsigned* bar, unsigned x, unsigned& nloc, unsigned& nx) {
    const unsigned G = gridDim.x * gridDim.y * gridDim.z;
    unsigned sum, cnt, mine, sp = 0u;
    for (;;) {
        sum = 0u; cnt = 0u; mine = 0u;
#pragma unroll
        for (unsigned j = 0; j < 16; ++j) { const unsigned c = xb_ld(&bar[XB_XCNT(j)]); sum += c; cnt += (c > 0u) ? 1u : 0u; mine = (j == x) ? c : mine; }
        if (sum == G) break;
        __builtin_amdgcn_s_sleep(1);
        if ((++sp & 255u) == 0u) { if (xb_ld(&bar[XB_TMO])) break; if (sp > XB_SPIN_CAP) { atomicAdd(&bar[XB_TMO], 1u); break; } }
    }
    nloc = mine > 0u ? mine : 1u; nx = cnt > 0u ? cnt : 1u;
}

__device__ __forceinline__ void xcd_barrier(const XcdBarrier& b) {
    asm volatile("s_waitcnt vmcnt(0)" ::: "memory");
    __syncthreads();
    if (threadIdx.x == 0) {
        unsigned* bar = b.bar;
        __builtin_amdgcn_s_waitcnt(0);
        unsigned nloc = b.st[0], nx = b.st[1];
        if (nloc == 0u) { xcd_barrier_complete(bar, b.x, nloc, nx); b.st[0] = nloc; b.st[1] = nx; }
        const unsigned old = xb_add(&bar[XB_XSUB(b.x)], 1u);
        const unsigned gen = old / nloc;
        if (old + 1u == (gen + 1u) * nloc) {
            __builtin_amdgcn_fence(__ATOMIC_RELEASE, "agent");
            asm volatile("s_waitcnt vmcnt(0)" ::: "memory");
            const unsigned og = xb_add(&bar[XB_TOP], 1u);
            const unsigned tg = og / nx;
            if (og + 1u == (tg + 1u) * nx) xb_add(&bar[XB_TOPGEN], 1u);
            else XB_SPIN(xb_ld(&bar[XB_TOPGEN]) == tg, bar);
            __builtin_amdgcn_fence(__ATOMIC_ACQUIRE, "agent");
            xb_add(&bar[XB_XGEN(b.x)], 1u);
            asm volatile("s_waitcnt vmcnt(0)" ::: "memory");
        } else {
            XB_SPIN(xb_ld(&bar[XB_XGEN(b.x)]) == gen, bar);
            __builtin_amdgcn_fence(__ATOMIC_ACQUIRE, "agent");
            asm volatile("s_waitcnt vmcnt(0)" ::: "memory");
        }
    }
    __syncthreads();
}
struct ConvArgs { bf16* P; bf16* XBC; const float *conv_w, *conv_b, *qnw, *knw; const int* pos; };
__device__ __forceinline__ void cvt8(const v4u r, float (&f)[8]) { f[0] = bf_lo(r.x); f[1] = bf_hi(r.x); f[2] = bf_lo(r.y); f[3] = bf_hi(r.y); f[4] = bf_lo(r.z); f[5] = bf_hi(r.z); f[6] = bf_lo(r.w); f[7] = bf_hi(r.w); }
__device__ __forceinline__ void conv_phase(const Frame& F, const ConvArgs& A) {
    for (int item = F.vcu; item < BATCH * NCHUNK; item += F.G) {
        const int b = item / NCHUNK, c = item % NCHUNK;
        const size_t rowb = (size_t)b * SEQ;
        {
            const int cg8 = F.tid & 127, ch = cg8 * 8;
            float w[5][8], bias[8];
#pragma unroll
            for (int k = 0; k < 5; ++k) { const f32x4 a = *(const f32x4*)(A.conv_w + k * 1024 + ch), d = *(const f32x4*)(A.conv_w + k * 1024 + ch + 4);
                w[k][0] = a.x; w[k][1] = a.y; w[k][2] = a.z; w[k][3] = a.w; w[k][4] = d.x; w[k][5] = d.y; w[k][6] = d.z; w[k][7] = d.w; }
            { const f32x4 a = *(const f32x4*)(A.conv_b + ch), d = *(const f32x4*)(A.conv_b + ch + 4); bias[0] = a.x; bias[1] = a.y; bias[2] = a.z; bias[3] = a.w; bias[4] = d.x; bias[5] = d.y; bias[6] = d.z; bias[7] = d.w; }
#pragma unroll 1
            for (int it = 0; it < 4; ++it) {
                const int t0 = c * CH + ((F.tid >> 7) + 4 * it) * 8;
                v4u rows[12];
#pragma unroll
                for (int j = 0; j < 12; ++j) { const int t = t0 - 2 + j; rows[j] = (v4u){0u, 0u, 0u, 0u}; if (t >= 0 && t < SEQ) rows[j] = *(const v4u*)(A.P + (rowb + t) * NPROJ + PXBC + ch); }
#pragma unroll
                for (int i = 0; i < 8; ++i) {
                    float f0[8], f1[8], f2[8], f3[8], f4[8], o[8];
                    cvt8(rows[i], f0); cvt8(rows[i + 1], f1); cvt8(rows[i + 2], f2); cvt8(rows[i + 3], f3); cvt8(rows[i + 4], f4);
#pragma unroll
                    for (int j = 0; j < 8; ++j) { const float v = bias[j] + w[0][j] * f0[j] + w[1][j] * f1[j] + w[2][j] * f2[j] + w[3][j] * f3[j] + w[4][j] * f4[j]; o[j] = silu_f(v); }
                    v4u ov; ov.x = pk2(o[0], o[1]); ov.y = pk2(o[2], o[3]); ov.z = pk2(o[4], o[5]); ov.w = pk2(o[6], o[7]);
                    *(v4u*)(A.XBC + (rowb + t0 + i) * 1024 + ch) = ov;
                }
            }
        }
#pragma unroll 1
        for (int it4 = 0; it4 < 5; ++it4) {
            v4u raw[4];
#pragma unroll
            for (int u = 0; u < 4; ++u) { const int sidx = F.tid + NTHR * (4 * it4 + u), tok = sidx / 80, slot = sidx % 80; raw[u] = *(const v4u*)(A.P + (rowb + c * CH + tok) * NPROJ + PQ + slot * 8); }
#pragma unroll
            for (int u = 0; u < 4; ++u) {
                const int sidx = F.tid + NTHR * (4 * it4 + u), tok = sidx / 80, slot = sidx % 80, head = slot >> 3, part = slot & 7;
                const int t = c * CH + tok;
                bf16* p = A.P + (rowb + t) * NPROJ + PQ + slot * 8;
                float v[8]; cvt8(raw[u], v);
                float ss = 0.f;
#pragma unroll
                for (int j = 0; j < 8; ++j) ss += v[j] * v[j];
                ss += __shfl_xor(ss, 1); ss += __shfl_xor(ss, 2); ss += __shfl_xor(ss, 4);
                const float rstd = rsqrtf(ss * (1.f / 64.f) + EPS);
                const float* nw = (head < 8 ? A.qnw : A.knw) + part * 8;
                const f32x4 w0 = *(const f32x4*)nw, w1 = *(const f32x4*)(nw + 4);
                v[0] *= rstd * w0.x; v[1] *= rstd * w0.y; v[2] *= rstd * w0.z; v[3] *= rstd * w0.w; v[4] *= rstd * w1.x; v[5] *= rstd * w1.y; v[6] *= rstd * w1.z; v[7] *= rstd * w1.w;
                float oth[8];
#pragma unroll
                for (int j = 0; j < 8; ++j) oth[j] = __shfl_xor(v[j], 1);
                if (part < 2) {
                    const float posf = (float)A.pos[rowb + t];
                    const float sgn = part == 0 ? -1.f : 1.f;
                    const float inv[8] = {1.0f, 0.19392274f, 0.03760603f, 0.0072926646f, 0.0014142136f, 0.00027424819f, 5.3182957e-05f, 1.0313385e-05f};
#pragma unroll
                    for (int j = 0; j < 8; ++j) {
                        const float ang = posf * inv[j];
                        const float nrev = rintf(ang * 0.15915494309189535f);
                        float rr = fmaf(-nrev, 6.2831855f, ang); rr = fmaf(-nrev, -1.7484555e-7f, rr);
                        const float sn = __sinf(rr), cs = __cosf(rr);
                        v[j] = v[j] * cs + sgn * oth[j] * sn;
                    }
                }
                const float sc = head < 8 ? QSCALE : 1.0f;
                v4u ov; ov.x = pk2(v[0] * sc, v[1] * sc); ov.y = pk2(v[2] * sc, v[3] * sc); ov.z = pk2(v[4] * sc, v[5] * sc); ov.w = pk2(v[6] * sc, v[7] * sc);
                *(v4u*)p = ov;
            }
        }
    }
}
template <int NCOL>
__device__ __forceinline__ void stage_load(const Frame& F, v4u* tmp, const bf16* src, size_t row0, int src_pitch, int col0) {
    constexpr int CPR = NCOL / 8, PER = 128 * CPR / NTHR;
#pragma unroll
    for (int j = 0; j < PER; ++j) { const int i = F.tid + NTHR * j, r = i / CPR, cc = i % CPR; tmp[j] = *(const v4u*)(src + (row0 + r) * src_pitch + col0 + cc * 8); }
}
template <int NCOL>
__device__ __forceinline__ void stage_store(const Frame& F, const v4u* tmp, LAS unsigned char* dst, int dst_pitch) {
    constexpr int CPR = NCOL / 8, PER = 128 * CPR / NTHR;
#pragma unroll
    for (int j = 0; j < PER; ++j) { const int i = F.tid + NTHR * j, r = i / CPR, cc = i % CPR; *(LAS v4u*)(dst + r * dst_pitch + cc * 16) = tmp[j]; }
}
__device__ __forceinline__ void scan128(float& lo, float& hi, float& total, int lane) {
#pragma unroll
    for (int o = 1; o < 64; o <<= 1) { const float a = __shfl_up(lo, o), b2 = __shfl_up(hi, o); if (lane >= o) { lo += a; hi += b2; } }
    const float tl = __shfl(lo, 63); hi += tl; total = __shfl(hi, 63);
}
struct SsdArgs { const bf16* P; const bf16* XBC; const float* DT; const float *a_log, *d_skip, *ssd_nw; bf16* ST; float* CD; bf16* Y; float* ssq; };

__device__ __forceinline__ void ssd_states_phase(const Frame& F, const SsdArgs& A) {
    LAS unsigned char* Xs = F.lds + L_XS; LAS unsigned char* Bs = F.lds + L_BS; LAS float* wts = (LAS float*)(F.lds + L_ARR);
    const int lane = F.lane, h5 = lane >> 5;
    for (int item = F.vcu; item < BATCH * NCHUNK * 2; item += F.G) {
        const int g = item / (BATCH * NCHUNK), bc = item % (BATCH * NCHUNK), b = bc / NCHUNK, c = bc % NCHUNK;
        const size_t row0 = (size_t)b * SEQ + (size_t)c * CH;
        __syncthreads();
        const int hh = F.wave & 3, dir = F.wave >> 2, h = 4 * g + hh;
        const float dt0 = A.DT[(row0 + lane) * 16 + dir * 8 + h], dt1 = A.DT[(row0 + 64 + lane) * 16 + dir * 8 + h];
        {
            v4u tx[8], tb[4];
            stage_load<256>(F, tx, A.XBC, row0, 1024, g * 256); stage_load<128>(F, tb, A.XBC, row0, 1024, 512 + g * 128);
            stage_store<256>(F, tx, Xs, XS_PITCH); stage_store<128>(F, tb, Bs, BS_PITCH);
        }
        {
            const float a = -__expf(A.a_log[dir * 8 + h]);
            const float da0 = dt0 * a, da1 = dt1 * a;
            float p0 = da0, p1 = da1, tot; scan128(p0, p1, tot, lane);
            float w0, w1;
            if (dir == 0) { w0 = __expf(tot - p0) * dt0; w1 = __expf(tot - p1) * dt1; }
            else          { w0 = __expf(p0 - da0) * dt0; w1 = __expf(p1 - da1) * dt1; }
            wts[F.wave * 128 + lane] = w0; wts[F.wave * 128 + 64 + lane] = w1;
            if (lane == 0) A.CD[(bc * 2 + dir) * 8 + h] = __expf(tot);
        }
        __syncthreads();
        f32x16 acc[4][2];
#pragma unroll
        for (int nt = 0; nt < 4; ++nt)
#pragma unroll
            for (int pt = 0; pt < 2; ++pt)
#pragma unroll
                for (int r = 0; r < 16; ++r) acc[nt][pt][r] = 0.f;
#pragma unroll 2
        for (int ks = 0; ks < 8; ++ks) {
            const int s0 = 16 * ks + 8 * h5;
            const f32x4 wa = *(const LAS f32x4*)(wts + F.wave * 128 + s0), wb = *(const LAS f32x4*)(wts + F.wave * 128 + s0 + 4);
            const float wv[8] = {wa.x, wa.y, wa.z, wa.w, wb.x, wb.y, wb.z, wb.w};
            bf16x8 xb[2];
#pragma unroll
            for (int pt = 0; pt < 2; ++pt) {
                const bf16x8 raw = frag_tr(Xs, XS_PITCH, s0, s0 + 4, hh * 64 + 32 * pt, lane);
                v4u pk;
                pk.x = pk2(__uint_as_float(((unsigned)(unsigned short)raw[0]) << 16) * wv[0], __uint_as_float(((unsigned)(unsigned short)raw[1]) << 16) * wv[1]);
                pk.y = pk2(__uint_as_float(((unsigned)(unsigned short)raw[2]) << 16) * wv[2], __uint_as_float(((unsigned)(unsigned short)raw[3]) << 16) * wv[3]);
                pk.z = pk2(__uint_as_float(((unsigned)(unsigned short)raw[4]) << 16) * wv[4], __uint_as_float(((unsigned)(unsigned short)raw[5]) << 16) * wv[5]);
                pk.w = pk2(__uint_as_float(((unsigned)(unsigned short)raw[6]) << 16) * wv[6], __uint_as_float(((unsigned)(unsigned short)raw[7]) << 16) * wv[7]);
                xb[pt] = __builtin_bit_cast(bf16x8, pk);
            }
#pragma unroll
            for (int nt = 0; nt < 4; ++nt) {
                const bf16x8 bt = frag_tr_perm(Bs, BS_PITCH, s0, s0 + 4, 64 * (nt >> 1), nt & 1, lane);
#pragma unroll
                for (int pt = 0; pt < 2; ++pt) acc[nt][pt] = mfma32(bt, xb[pt], acc[nt][pt]);
            }
        }
        bf16* st = A.ST + ((size_t)((bc * 2 + dir) * 8 + h)) * 8192;
#pragma unroll
        for (int nt = 0; nt < 4; ++nt)
#pragma unroll
            for (int pt = 0; pt < 2; ++pt) { bf16* dst = st + (32 * pt + (lane & 31)) * 128 + 64 * (nt >> 1) + 32 * h5 + 16 * (nt & 1);
                v4u w0, w1; w0.x = pk2(acc[nt][pt][0], acc[nt][pt][1]); w0.y = pk2(acc[nt][pt][2], acc[nt][pt][3]); w0.z = pk2(acc[nt][pt][4], acc[nt][pt][5]); w0.w = pk2(acc[nt][pt][6], acc[nt][pt][7]);
                w1.x = pk2(acc[nt][pt][8], acc[nt][pt][9]); w1.y = pk2(acc[nt][pt][10], acc[nt][pt][11]); w1.z = pk2(acc[nt][pt][12], acc[nt][pt][13]); w1.w = pk2(acc[nt][pt][14], acc[nt][pt][15]);
                *(v4u*)dst = w0; *(v4u*)(dst + 8) = w1; }
    }
}

__device__ __forceinline__ void ssd_scan_phase(const Frame& F, const SsdArgs& A) {
    const int gt = F.vcu * NTHR + F.tid, NT = F.G * NTHR;
    for (int e = gt; e < BATCH * 2 * 8 * 64 * 32; e += NT) {
        const int n4 = e & 31, p = (e >> 5) & 63, h = (e >> 11) & 7, dir = (e >> 14) & 1, b = e >> 15;
        float st[4] = {0.f, 0.f, 0.f, 0.f};
        for (int c8 = 0; c8 < NCHUNK; c8 += 16) {
            v2u v[16]; float cd[16];
#pragma unroll
            for (int j = 0; j < 16; ++j) { const int c = dir == 0 ? (c8 + j) : (NCHUNK - 1 - c8 - j); const int bc = b * NCHUNK + c;
                v[j] = *(const v2u*)(A.ST + ((size_t)((bc * 2 + dir) * 8 + h)) * 8192 + p * 128 + 4 * n4); cd[j] = A.CD[(bc * 2 + dir) * 8 + h]; }
#pragma unroll
            for (int j = 0; j < 16; ++j) { const int c = dir == 0 ? (c8 + j) : (NCHUNK - 1 - c8 - j); const int bc = b * NCHUNK + c;
                v2u o; o.x = pk2(st[0], st[1]); o.y = pk2(st[2], st[3]);
                *(v2u*)(A.ST + ((size_t)((bc * 2 + dir) * 8 + h)) * 8192 + p * 128 + 4 * n4) = o;
                st[0] = st[0] * cd[j] + bf_lo(v[j].x); st[1] = st[1] * cd[j] + bf_hi(v[j].x); st[2] = st[2] * cd[j] + bf_lo(v[j].y); st[3] = st[3] * cd[j] + bf_hi(v[j].y); }
        }
    }
}
struct AttnArgs { const bf16* P; bf16* Y; const float* sink; const float *qnw, *knw; const float* ssq; };
__device__ __forceinline__ void attn_phase(const Frame& F, const AttnArgs& A) {
    LAS unsigned char* Ks = F.lds; LAS unsigned char* Vs = F.lds + 384 * KV_PITCH;
    const int lane = F.lane, h5 = lane >> 5, r32 = lane & 31;
    float mref;
    { float a = fabsf(A.qnw[lane]), b2 = fabsf(A.knw[lane]);
#pragma unroll
      for (int o = 1; o < 64; o <<= 1) { a = fmaxf(a, __shfl_xor(a, o)); b2 = fmaxf(b2, __shfl_xor(b2, o)); }
      mref = fminf(8.0f * LOG2E * a * b2 * 1.01f + 0.5f, 100.f); }
    v4u kt[6], vt[6];
    auto kv_fetch = [&](int item) {
        const int kvh = item / (BATCH * NCHUNK), bq = item % (BATCH * NCHUNK), b = bq / NCHUNK, qb = bq % NCHUNK; const size_t rowb = (size_t)b * SEQ;
#pragma unroll
        for (int jj = 0; jj < 6; ++jj) { const int i = F.tid + NTHR * jj, r = i >> 3, cc = i & 7, j = qb * 128 - 128 + r;
            kt[jj] = (v4u){0u, 0u, 0u, 0u}; vt[jj] = (v4u){0u, 0u, 0u, 0u};
            if (j >= 0 && j < SEQ) { const bf16* src = A.P + (rowb + j) * NPROJ + kvh * 64 + cc * 8; kt[jj] = *(const v4u*)(src + PK); vt[jj] = *(const v4u*)(src + PV); } }
    };
    if (F.vcu < BATCH * NCHUNK * 2) kv_fetch(F.vcu);
    for (int item = F.vcu; item < BATCH * NCHUNK * 2; item += F.G) {
        const int kvh = item / (BATCH * NCHUNK), bq = item % (BATCH * NCHUNK), b = bq / NCHUNK, qb = bq % NCHUNK;
        const size_t rowb = (size_t)b * SEQ;
        __syncthreads();
#pragma unroll
        for (int jj = 0; jj < 6; ++jj) { const int i = F.tid + NTHR * jj, r = i >> 3, cc = i & 7;
            *(LAS v4u*)(Ks + r * KV_PITCH + cc * 16) = kt[jj]; *(LAS v4u*)(Vs + r * KV_PITCH + cc * 16) = vt[jj]; }
        __syncthreads();
        if (item + F.G < BATCH * NCHUNK * 2) kv_fetch(item + F.G);
        const int hq = kvh * 4 + (F.wave & 3), qhalf = F.wave >> 2;
        const float sinkl = A.sink[hq] * LOG2E;
#pragma unroll 1
        for (int qt = 0; qt < 2; ++qt) {
            const int o = 64 * qhalf + 32 * qt;
            const int ir = o + r32;
            bf16x8 qf[4];
            { const bf16* qp = A.P + (rowb + qb * 128 + ir) * NPROJ + PQ + hq * 64 + 8 * h5;
#pragma unroll
              for (int kd = 0; kd < 4; ++kd) qf[kd] = *(const bf16x8*)(qp + 16 * kd); }
            float lsum = h5 == 0 ? __builtin_amdgcn_exp2f(sinkl - mref) : 0.0f;
            f32x16 oacc[2];
#pragma unroll
            for (int r = 0; r < 16; ++r) { oacc[0][r] = 0.f; oacc[1][r] = 0.f; }
#pragma unroll 1
            for (int ks = 0; ks < 6; ++ks) {
                const int kstart = -128 + 64 * ks;
                if (kstart > o + 31 + 128 || kstart + 63 < o - 128) continue;
                f32x16 st[2];
#pragma unroll
                for (int kt = 0; kt < 2; ++kt) {
#pragma unroll
                    for (int r = 0; r < 16; ++r) st[kt][r] = -mref;
#pragma unroll
                    for (int kd = 0; kd < 4; ++kd) st[kt] = mfma32(frag_row(Ks, KV_PITCH, 64 * ks + 32 * kt, 16 * kd, lane), qf[kd], st[kt]);
                }
                const bool interior = (kstart >= o + 31 - 128) && (kstart + 63 <= o + 128) && (qb * 128 + kstart >= 0) && (qb * 128 + kstart + 63 < SEQ);
                if (!interior) {
#pragma unroll
                    for (int kt = 0; kt < 2; ++kt)
#pragma unroll
                        for (int r = 0; r < 16; ++r) { const int jr = kstart + 32 * kt + crow(r, h5); const int dlt = ir - jr; const int jg = qb * 128 + jr;
                            const bool ok = dlt <= 128 && dlt >= -128 && jg >= 0 && jg < SEQ;
                            st[kt][r] = ok ? st[kt][r] : -1e30f; }
                }
                float ps = 0.f;
#pragma unroll
                for (int kt = 0; kt < 2; ++kt)
#pragma unroll
                    for (int r = 0; r < 16; ++r) { const float p = __builtin_amdgcn_exp2f(st[kt][r]); st[kt][r] = p; ps += p; }
                lsum += ps;
#pragma unroll
                for (int kt = 0; kt < 2; ++kt)
#pragma unroll
                    for (int s2 = 0; s2 < 2; ++s2) {
                        const bf16x8 pf = pack_step(st[kt], s2);
                        const int key0 = 64 * ks + 32 * kt + 16 * s2 + 4 * h5;
#pragma unroll
                        for (int dt = 0; dt < 2; ++dt) oacc[dt] = mfma32(frag_tr_perm(Vs, KV_PITCH, key0, key0 + 8, 0, dt, lane), pf, oacc[dt]);
                    }
            }
            lsum += __shfl_xor(lsum, 32);
            const float inv = sqrtf(__hip_atomic_load(A.ssq + rowb + qb * 128 + ir, __ATOMIC_RELAXED, __HIP_MEMORY_SCOPE_AGENT) * (1.f / 512.f) + EPS) / lsum;
            bf16* yp = A.Y + (rowb + qb * 128 + ir) * 1024 + 512 + hq * 64 + 32 * h5;
#pragma unroll
            for (int dt = 0; dt < 2; ++dt) {
                v4u w0, w1; w0.x = pk2(oacc[dt][0] * inv, oacc[dt][1] * inv); w0.y = pk2(oacc[dt][2] * inv, oacc[dt][3] * inv); w0.z = pk2(oacc[dt][4] * inv, oacc[dt][5] * inv); w0.w = pk2(oacc[dt][6] * inv, oacc[dt][7] * inv);
                w1.x = pk2(oacc[dt][8] * inv, oacc[dt][9] * inv); w1.y = pk2(oacc[dt][10] * inv, oacc[dt][11] * inv); w1.z = pk2(oacc[dt][12] * inv, oacc[dt][13] * inv); w1.w = pk2(oacc[dt][14] * inv, oacc[dt][15] * inv);
                *(v4u*)(yp + 16 * dt) = w0; *(v4u*)(yp + 16 * dt + 8) = w1; }
        }
    }
}
__device__ __forceinline__ void ssd_out_phase(const Frame& F, const SsdArgs& A) {
    LAS unsigned char* Xs = F.lds + L_XS; LAS unsigned char* Bs = F.lds + L_BS; LAS unsigned char* Cs = F.lds + L_CS;
    LAS float* arr = (LAS float*)(F.lds + L_ARR);
    const int lane = F.lane, h5 = lane >> 5, r32 = lane & 31;
    const int hh = F.wave & 3, lhalf = F.wave >> 2;
    for (int item = F.vcu; item < BATCH * NCHUNK * 2; item += F.G) {
        const int g = item / (BATCH * NCHUNK), bc = item % (BATCH * NCHUNK), b = bc / NCHUNK, c = bc % NCHUNK;
        const size_t row0 = (size_t)b * SEQ + (size_t)c * CH;
        const int h = 4 * g + hh;
        __syncthreads();
        {
            const int dir = F.wave >> 2;
            const float dt0 = A.DT[(row0 + lane) * 16 + dir * 8 + h], dt1 = A.DT[(row0 + 64 + lane) * 16 + dir * 8 + h];
            {
                v4u tx[8], tb[4], tc[4];
                stage_load<256>(F, tx, A.XBC, row0, 1024, g * 256); stage_load<128>(F, tb, A.XBC, row0, 1024, 512 + g * 128); stage_load<128>(F, tc, A.XBC, row0, 1024, 768 + g * 128);
                stage_store<256>(F, tx, Xs, XS_PITCH); stage_store<128>(F, tb, Bs, BS_PITCH); stage_store<128>(F, tc, Cs, BS_PITCH);
            }
            const float a = -__expf(A.a_log[dir * 8 + h]);
            const float da0 = dt0 * a, da1 = dt1 * a;
            float p0 = da0, p1 = da1, tot; scan128(p0, p1, tot, lane);
            LAS float* cs = arr + (2 * dir) * 512 + hh * 128; LAS float* dts = arr + (2 * dir + 1) * 512 + hh * 128;
            if (dir == 0) { cs[lane] = p0; cs[64 + lane] = p1; } else { cs[lane] = tot - p0 + da0; cs[64 + lane] = tot - p1 + da1; }
            dts[lane] = dt0; dts[64 + lane] = dt1;
        }
        __syncthreads();
        const float dsk = A.d_skip[h];
        const LAS float* csf = arr + hh * 128; const LAS float* dtf = arr + 512 + hh * 128; const LAS float* rsb = arr + 1024 + hh * 128; const LAS float* dtb = arr + 1536 + hh * 128;
#pragma unroll 1
        for (int lt2 = 0; lt2 < 2; ++lt2) {
            const int lt = 2 * lhalf + lt2, l = 32 * lt + r32;
            const float my_cs = csf[l], my_rs = rsb[l];
            const int ch0 = h * 64 + 32 * h5;
            v4u zz[4];
            { const bf16* zp = A.P + (row0 + l) * NPROJ + PZ + ch0;
#pragma unroll
              for (int q = 0; q < 4; ++q) zz[q] = *(const v4u*)(zp + 8 * q); }
            f32x16 yacc[2];
#pragma unroll
            for (int r = 0; r < 16; ++r) { yacc[0][r] = 0.f; yacc[1][r] = 0.f; }
            bf16x8 cf[8];
#pragma unroll
            for (int kn = 0; kn < 8; ++kn) cf[kn] = frag_row(Cs, BS_PITCH, 32 * lt, 16 * kn, lane);
#pragma unroll 1
            for (int st = 0; st < 4; ++st) {
                f32x16 cbt;
#pragma unroll
                for (int r = 0; r < 16; ++r) cbt[r] = 0.f;
#pragma unroll
                for (int kn = 0; kn < 8; ++kn) cbt = mfma32(frag_row(Bs, BS_PITCH, 32 * st, 16 * kn, lane), cf[kn], cbt);
#pragma unroll
                for (int g4 = 0; g4 < 4; ++g4) {
                    const int sb = 32 * st + 8 * g4 + 4 * h5;
                    const f32x4 c4 = *(const LAS f32x4*)(csf + sb), d4 = *(const LAS f32x4*)(dtf + sb), r4 = *(const LAS f32x4*)(rsb + sb), e4 = *(const LAS f32x4*)(dtb + sb);
#pragma unroll
                    for (int i = 0; i < 4; ++i) { const int s = sb + i; const bool fwd = s <= l;
                        const float e = fwd ? (my_cs - c4[i]) : (my_rs - r4[i]); const float dtv = fwd ? d4[i] : e4[i];
                        float mval = cbt[4 * g4 + i] * __expf(e) * dtv; if (s == l) mval += dsk; cbt[4 * g4 + i] = mval; }
                }
#pragma unroll
                for (int s2 = 0; s2 < 2; ++s2) {
                    const bf16x8 mf = pack_step(cbt, s2);
                    const int sA = 32 * st + 16 * s2 + 4 * h5;
#pragma unroll
                    for (int pt = 0; pt < 2; ++pt) yacc[pt] = mfma32(frag_tr_perm(Xs, XS_PITCH, sA, sA + 8, hh * 64, pt, lane), mf, yacc[pt]);
                }
            }
#pragma unroll 1
            for (int dir = 0; dir < 2; ++dir) {
                const bf16* stp = A.ST + ((size_t)((bc * 2 + dir) * 8 + h)) * 8192 + 8 * h5;
                bf16x8 sf[2][8];
#pragma unroll
                for (int pt = 0; pt < 2; ++pt)
#pragma unroll
                    for (int kn = 0; kn < 8; ++kn) sf[pt][kn] = *(const bf16x8*)(stp + perm_row(r32, pt) * 128 + 16 * kn);
                const float ef = __expf(dir == 0 ? my_cs : my_rs);
#pragma unroll
                for (int kn = 0; kn < 8; ++kn) {
                    const v4u cw = __builtin_bit_cast(v4u, cf[kn]);
                    v4u sw; sw.x = pk2(bf_lo(cw.x) * ef, bf_hi(cw.x) * ef); sw.y = pk2(bf_lo(cw.y) * ef, bf_hi(cw.y) * ef); sw.z = pk2(bf_lo(cw.z) * ef, bf_hi(cw.z) * ef); sw.w = pk2(bf_lo(cw.w) * ef, bf_hi(cw.w) * ef);
                    const bf16x8 cs8 = __builtin_bit_cast(bf16x8, sw);
#pragma unroll
                    for (int pt = 0; pt < 2; ++pt) yacc[pt] = mfma32(sf[pt][kn], cs8, yacc[pt]);
                }
            }
            {
                bf16* yp = A.Y + (row0 + l) * 1024 + ch0;
                float sq = 0.f;
#pragma unroll
                for (int q = 0; q < 4; ++q) {
                    const int pt = q >> 1, r0 = 8 * (q & 1);
                    const f32x4 nw0 = *(const f32x4*)(A.ssd_nw + ch0 + 8 * q), nw1 = *(const f32x4*)(A.ssd_nw + ch0 + 8 * q + 4);
                    float zf[8]; cvt8(zz[q], zf);
                    float y[8];
#pragma unroll
                    for (int i = 0; i < 8; ++i) { y[i] = yacc[pt][r0 + i] * silu_f(zf[i]); sq += y[i] * y[i]; }
                    v4u w; w.x = pk2(y[0] * nw0.x, y[1] * nw0.y); w.y = pk2(y[2] * nw0.z, y[3] * nw0.w); w.z = pk2(y[4] * nw1.x, y[5] * nw1.y); w.w = pk2(y[6] * nw1.z, y[7] * nw1.w);
                    *(v4u*)(yp + 8 * q) = w;
                }
                sq += __shfl_xor(sq, 32);
                if (h5 == 0) __hip_atomic_fetch_add(A.ssq + row0 + l, sq, __ATOMIC_RELAXED, __HIP_MEMORY_SCOPE_AGENT);
            }
        }
    }
}
#ifndef MK_ONE_LAUNCH
#define MK_ONE_LAUNCH 1
#endif
constexpr int NPHASE = 12;
struct Args { const float* in[25]; float* out; unsigned char* ws; int ph_lo, ph_hi; };
__global__ void __launch_bounds__(NTHR, 2) hybrid_fwd(Args args) {
    extern __shared__ __attribute__((aligned(16))) unsigned char lds_raw[];
    Frame F;
    F.lds = (LAS unsigned char*)lds_raw;
    F.tid = threadIdx.x; F.lane = F.tid & 63; F.wave = __builtin_amdgcn_readfirstlane(F.tid >> 6);
    F.G = gridDim.x; { const int bx = blockIdx.x; F.vcu = (F.G % 8 == 0) ? (bx % 8) * (F.G / 8) + bx / 8 : bx; }
    unsigned char* ws = args.ws;
    const float* x = args.in[0]; const float* cvec = args.in[1]; const int* pos = (const int*)args.in[2];
    const float *w_ada = args.in[3], *b_ada = args.in[4], *norm_ffn1 = args.in[5], *ffn1_wg = args.in[6], *ffn1_wu = args.in[7], *ffn1_wd = args.in[8], *norm_mix = args.in[9], *w_in = args.in[10];
    const float *conv_w = args.in[11], *conv_b = args.in[12], *dt_bias = args.in[13], *a_log = args.in[14], *d_skip = args.in[15], *ssd_nw = args.in[16], *qnw = args.in[17], *knw = args.in[18], *sink = args.in[19];
    const float *w_out = args.in[20], *norm_ffn2 = args.in[21], *ffn2_wg = args.in[22], *ffn2_wu = args.in[23], *ffn2_wd = args.in[24];
    float* out = args.out;
    float* mod = (float*)(ws + WS_CTL + CTL_MOD);
    bf16 *WGU1 = (bf16*)(ws + WS_WGU1), *WD1 = (bf16*)(ws + WS_WD1), *WINB = (bf16*)(ws + WS_WINB), *WOUT = (bf16*)(ws + WS_WOUT), *WGU2B = (bf16*)(ws + WS_WGU2B), *WD2 = (bf16*)(ws + WS_WD2);
    float* DT = (float*)(ws + WS_DT); float* CD = (float*)(ws + WS_CD); float* ssq = (float*)(ws + WS_CTL + CTL_SSQ); float* rssq1 = (float*)(ws + WS_CTL + CTL_RSSQ1); float* rssq2 = (float*)(ws + WS_CTL + CTL_RSSQ2); float* sW2 = (float*)(ws + WS_CTL + CTL_SW2); float* rowsc = (float*)(ws + WS_CTL + CTL_ROWSC); unsigned* cmax = (unsigned*)(ws + WS_CTL + CTL_CMAX); float* colsc = (float*)(ws + WS_CTL + CTL_COLSC);
    signed char* WGU1Q = (signed char*)(ws + WS_WGU1); signed char* WGU2Q = (signed char*)(ws + WS_WGU2); signed char* UQ = (signed char*)(ws + WS_U);
    bf16 *U = (bf16*)(ws + WS_U), *H = (bf16*)(ws + WS_H), *P = (bf16*)(ws + WS_H), *XBC = (bf16*)out, *ST = (bf16*)out + (size_t)M * 1024, *X1 = (bf16*)(ws + WS_X1);
    const int lo = args.ph_lo, hi = args.ph_hi;
    cg::grid_group grid = cg::this_grid();
    volatile LAS unsigned* xbst = (volatile LAS unsigned*)(F.lds + L_END);
    if (F.tid < 2) xbst[F.tid] = 0u;
    __syncthreads();
    XcdBarrier bar; bar.bar = (unsigned*)(ws + WS_CTL + CTL_BAR); bar.x = 0; bar.st = xbst;
    if (hi - lo > 1) bar = xcd_barrier_post((unsigned*)(ws + WS_CTL + CTL_BAR), xbst);
#ifndef PHM
#define PHM 0xffff
#endif
#ifndef WGM_N4
#define WGM_N4 2
#endif
#ifndef EPI_ALIGN
#define EPI_ALIGN true
#endif
#ifndef DUPM
#define DUPM 0
#endif
#define IN(k) (((PHM >> (k)) & 1) && lo <= (k) && (k) < hi)
#define SEAM(k) do { if (IN(k) && IN((k) + 1)) xcd_barrier(bar); } while (0)
#define DUP(k) (((DUPM >> (k)) & 1) != 0)
#define PHASE(k, ...) if (IN(k)) { __VA_ARGS__; if (DUP(k)) { xcd_barrier(bar); __VA_ARGS__; } } SEAM(k);
    if (lo > hi) grid.sync();
    PHASE(0, { P0Args A{ffn1_wg, ffn1_wu, ffn1_wd, w_out, ffn2_wd, cvec, w_ada, b_ada, ffn2_wg, ffn2_wu, WGU1, WD1, WOUT, WD2, mod, cmax}; p0_prologue(F, A); })
    PHASE(1, { norm_q_phase<false>(F, x, norm_ffn1, mod, 0, 1, UQ, rowsc); PrepArgs A{w_in, ffn1_wg, ffn1_wu, ffn2_wg, ffn2_wu, norm_mix, mod, WINB, sW2, WGU1Q, WGU2Q, cmax, colsc}; prep_phase(F, A); })
    PHASE(2, { pg8::Gemm g{(const bf16*)UQ, (const bf16*)WGU1Q, M, NGU, D / 2, 0, 1 << 30}; pg8::StaticOrder S; S.init(M, NGU, F.G, (int)blockIdx.x); pg8::EpiSwiGLUq E{H, rowsc, colsc, DFF};
        pg8::gemm_phase<pg8::EpiSwiGLUq, pg8::StaticOrder, true, true, true>(F.lds, g, S, E); })
    PHASE(3, { pg8::Gemm g{H, WD1, M, D, DFF, 0, 1 << 30}; pg8::StaticOrder S; S.init(M, D, F.G, (int)blockIdx.x, WGM_N4); pg8::EpiResid<false, true, false, true> E{x, X1, mod + 2 * D, nullptr, rssq1, D, NMOD, SEQ, 0.5f, 0.f};
        pg8::gemm_phase<pg8::EpiResid<false, true, false, true>, pg8::StaticOrder, EPI_ALIGN, true>(F.lds, g, S, E); })
    PHASE(4, { pg8::Gemm g{X1, WINB, M, NPROJ_PAD, D, (size_t)NPROJ_PAD * D * 2, SEQ / 256}; pg8::StaticOrder S; S.init(M, NPROJ_PAD, F.G, (int)blockIdx.x); pg8::EpiProj E{P, DT, dt_bias, rssq1, sW2, NPROJ, NPROJ / 256, NPROJ_PAD, SEQ};
        pg8::gemm_phase<pg8::EpiProj, pg8::StaticOrder, true, true>(F.lds, g, S, E); })
    PHASE(5, { ConvArgs A{P, XBC, conv_w, conv_b, qnw, knw, pos}; conv_phase(F, A); if (F.G != BATCH * NCHUNK) xcd_barrier(bar); else __syncthreads();
               SsdArgs B{P, XBC, DT, a_log, d_skip, ssd_nw, ST, CD, U, ssq}; ssd_states_phase(F, B); })
    PHASE(6, { SsdArgs A{P, XBC, DT, a_log, d_skip, ssd_nw, ST, CD, U, ssq}; ssd_scan_phase(F, A); })
    PHASE(7, { SsdArgs A{P, XBC, DT, a_log, d_skip, ssd_nw, ST, CD, U, ssq}; ssd_out_phase(F, A); if (F.G != BATCH * NCHUNK) xcd_barrier(bar); else __syncthreads();
               AttnArgs B{P, U, sink, qnw, knw, ssq}; attn_phase(F, B); })
    PHASE(8, { pg8::Gemm g{U, WOUT, M, D, D, 0, 1 << 30}; pg8::StaticOrder S; S.init(M, D, F.G, (int)blockIdx.x, WGM_N4); pg8::EpiResid<true, true, true, false> E{X1, X1, mod + 5 * D, ssq, nullptr, D, NMOD, SEQ, 1.0f, 1.f / 512.f};
        pg8::gemm_phase<pg8::EpiResid<true, true, true, false>, pg8::StaticOrder, EPI_ALIGN, true>(F.lds, g, S, E); })
    PHASE(9, { norm_q_phase<true>(F, X1, norm_ffn2, mod, 6, 7, UQ, rowsc); })
    PHASE(10, { pg8::Gemm g{(const bf16*)UQ, (const bf16*)WGU2Q, M, NGU, D / 2, 0, 1 << 30}; pg8::StaticOrder S; S.init(M, NGU, F.G, (int)blockIdx.x); pg8::EpiSwiGLUq E{H, rowsc, colsc + NGU, DFF};
        pg8::gemm_phase<pg8::EpiSwiGLUq, pg8::StaticOrder, true, true, true>(F.lds, g, S, E); })
    PHASE(11, { pg8::Gemm g{H, WD2, M, D, DFF, 0, 1 << 30}; pg8::StaticOrder S; S.init(M, D, F.G, (int)blockIdx.x, WGM_N4); pg8::EpiResid<true, false> E{X1, out, mod + 8 * D, nullptr, nullptr, D, NMOD, SEQ, 0.5f, 0.f};
        pg8::gemm_phase<pg8::EpiResid<true, false>, pg8::StaticOrder, EPI_ALIGN, true>(F.lds, g, S, E); })
#undef IN
#undef SEAM
}

extern "C" void kernel_launch(void* const* d_in, const int* in_sizes, int n_in, void* d_out, int out_size, void* d_ws, size_t ws_size, hipStream_t stream) {
    static int grid = 0;
    if (grid == 0) {
        if (n_in != 25 || in_sizes[0] != M * D || out_size != M * D || ws_size < WS_END) { fprintf(stderr, "kernel_launch: unexpected shapes (n_in %d, in0 %d, out %d, ws %zu)\n", n_in, n_in > 0 ? in_sizes[0] : -1, out_size, ws_size); grid = -1; return; }
        int dev = 0, cus = 0, per_cu = 0;
        if (hipGetDevice(&dev) != hipSuccess || hipDeviceGetAttribute(&cus, hipDeviceAttributeMultiprocessorCount, dev) != hipSuccess) { grid = -1; return; }
        if (hipFuncSetAttribute((const void*)hybrid_fwd, hipFuncAttributeMaxDynamicSharedMemorySize, LDS_BYTES) != hipSuccess) { fprintf(stderr, "kernel_launch: hipFuncSetAttribute failed\n"); grid = -1; return; }
        if (hipOccupancyMaxActiveBlocksPerMultiprocessor(&per_cu, (const void*)hybrid_fwd, NTHR, LDS_BYTES) != hipSuccess || per_cu < 1) { fprintf(stderr, "kernel_launch: occupancy query says %d\n", per_cu); per_cu = 1; }
        (void)hipGetLastError();
        grid = cus * per_cu;
        if (grid > 256) grid = 256;
    }
    if (grid < 0) return;
    if (hipMemsetAsync((char*)d_ws + WS_CTL, 0, CTL_ZERO_BYTES, stream) != hipSuccess) { fprintf(stderr, "kernel_launch: memset failed\n"); return; }
    Args a{};
    for (int i = 0; i < 25; ++i) a.in[i] = (const float*)d_in[i];
    a.out = (float*)d_out; a.ws = (unsigned char*)d_ws;
#if MK_ONE_LAUNCH
    a.ph_lo = 0; a.ph_hi = NPHASE;
    void* kargs[] = {&a};
    hipError_t e = hipLaunchCooperativeKernel((const void*)hybrid_fwd, dim3(grid), dim3(NTHR), kargs, LDS_BYTES, stream);
    if (e != hipSuccess) fprintf(stderr, "kernel_launch: cooperative launch failed: %s (grid %d)\n", hipGetErrorString(e), grid);
#else
    for (int p = 0; p < NPHASE; ++p) { a.ph_lo = p; a.ph_hi = p + 1; hipLaunchKernelGGL(hybrid_fwd, dim3(grid), dim3(NTHR), LDS_BYTES, stream, a); }
#endif
}
```

```cpp
#include <hip/hip_runtime.h>
#include <hip/hip_cooperative_groups.h>
#include <cstdio>
#include <cstdint>
namespace cg = cooperative_groups;
namespace pg8 {
#define PG8_LAS __attribute__((address_space(3)))
typedef unsigned short bf16_t;
typedef short bf16x8 __attribute__((ext_vector_type(8)));
typedef float f32x4 __attribute__((ext_vector_type(4)));
typedef unsigned u32x4 __attribute__((ext_vector_type(4)));
constexpr int BM = 256, BK = 64, HALF = 128, HTB = HALF * BK * 2  , STAGE_BYTES = 8 * HTB, NXCD = 8, WGM = 4;

__host__ __device__ __forceinline__ int lds_byte(int r, int c) { const int st = (r >> 4) * 2 + (c >> 5), rr = r & 15, cc = c & 31, ob = rr * 64 + cc * 2; return st * 1024 + (ob ^ (((ob >> 9) & 1) << 5)); }
__host__ __device__ __forceinline__ void stage_rc(int b, int& R, int& C) { const int st = b / 1024, sb = b % 1024, swz = sb ^ (((sb >> 9) & 1) << 5); R = (st >> 1) * 16 + swz / 64; C = (st & 1) * 32 + (swz % 64) / 2; }
__host__ __device__ __forceinline__ int perm32(int rho) { const int n = rho >> 4, i = rho & 15; return 8 * (i >> 2) + 4 * n + (i & 3); }

struct Unit { int pm, pn; };
struct Gemm { const bf16_t* A; const bf16_t* Bt; int M, N, K; size_t bstep; int pmb; };

struct StaticOrder {
    int nM, nN, nwg, G, c, wgm;
    __host__ __device__ void init(int M, int N, int G_, int c_, int wgm_ = WGM) { nM = M / BM; nN = N / BM; nwg = nM * nN; G = G_; c = c_; wgm = wgm_; }
    __host__ __device__ bool next(int i, Unit& u) const {
        const long L = (long)i * G + c; if (L >= nwg) return false;
        int wgid = (int)L; { const int q = nwg / NXCD, r = nwg % NXCD, xcd = wgid % NXCD, off = wgid / NXCD; wgid = (xcd < r ? xcd * (q + 1) : r * (q + 1) + (xcd - r) * q) + off; }
        const int nig = wgm * nN, gid = wgid / nig, fm = gid * wgm, gsz = (nM - fm) < wgm ? (nM - fm) : wgm;
        u.pm = fm + ((wgid % nig) % gsz); u.pn = (wgid % nig) / gsz; return true;
    }
    __device__ __forceinline__ void a_ready(const Unit&) const {}
    __device__ __forceinline__ void done(const Unit&) const {}
};

__device__ __forceinline__ unsigned cvt_pk_bf16(float lo, float hi) { unsigned r; asm volatile("v_cvt_pk_bf16_f32 %0, %1, %2" : "=v"(r) : "v"(lo), "v"(hi)); return r; }
typedef int i32x4 __attribute__((ext_vector_type(4)));
template <bool I8> struct AccSel { typedef f32x4 type; };
template <> struct AccSel<true> { typedef i32x4 type; };
template <class Epi, class Sched, bool ALIGN_EPI = false, bool SP2 = false, bool I8 = false>
__device__ __forceinline__ void gemm_phase(PG8_LAS unsigned char* lds, const Gemm g, const Sched& S, const Epi& E) {
    const int tid = threadIdx.x, wid = __builtin_amdgcn_readfirstlane(tid >> 6), lane = tid & 63, wr = wid >> 2, wc = wid & 3, fr = lane & 15, fq = lane >> 4;
    const int K = g.K, nt = K / BK;
    unsigned voffA[2], voffB[2];
#pragma unroll
    for (int i = 0; i < 2; ++i) { int R, C; stage_rc(tid * 16 + i * 8192, R, C); const int Rb = Epi::PERM ? ((R & ~31) + perm32(R & 31)) : R;
        voffA[i] = (unsigned)(R * K + C) * 2u; voffB[i] = (unsigned)(Rb * K + C) * 2u; }
    const size_t kstep = (size_t)(BK * 2);
    const size_t hstep = (size_t)HALF * K * 2;
    const size_t tstep = 2 * hstep;
    const unsigned ldsw = (unsigned)wid * 1024u;
    const int aoff = lds_byte(wr * 64 + fr, fq * 8), boff = lds_byte(wc * 32 + fr, fq * 8);
#define PG8_SA(b, h) (((b) * 2 + (h)) * HTB)
#define PG8_SB(b, h) ((4 + (b) * 2 + (h)) * HTB)
#define PG8_STAGE(bufoff, gbase, voff) do { _Pragma("unroll") for (int _i = 0; _i < 2; ++_i) \
        __builtin_amdgcn_global_load_lds((const unsigned*)((const char*)(gbase) + (voff)[_i]), (PG8_LAS unsigned*)(lds + (bufoff) + ldsw + _i * 8192), 16, 0, 0); } while (0)
#define PG8_LDA(dst, b, h) do { _Pragma("unroll") for (int m = 0; m < 4; ++m) _Pragma("unroll") for (int k = 0; k < 2; ++k) dst[m][k] = *(const PG8_LAS bf16x8*)(lds + PG8_SA(b, h) + aoff + m * 2048 + k * 1024); } while (0)
#define PG8_LDB(dst, b, h) do { _Pragma("unroll") for (int n = 0; n < 2; ++n) _Pragma("unroll") for (int k = 0; k < 2; ++k) dst[n][k] = *(const PG8_LAS bf16x8*)(lds + PG8_SB(b, h) + boff + n * 2048 + k * 1024); } while (0)
#define PG8_MMA(ai, bj, At, Bt) do { __builtin_amdgcn_s_setprio(1); _Pragma("unroll") for (int m = 0; m < 4; ++m) _Pragma("unroll") for (int n = 0; n < 2; ++n) _Pragma("unroll") for (int k = 0; k < 2; ++k) \
        { if constexpr (I8) acc[ai][bj][m][n] = __builtin_amdgcn_mfma_i32_16x16x64_i8(__builtin_bit_cast(i32x4, Bt[n][k]), __builtin_bit_cast(i32x4, At[m][k]), acc[ai][bj][m][n], 0, 0, 0); \
          else acc[ai][bj][m][n] = __builtin_amdgcn_mfma_f32_16x16x32_bf16(Bt[n][k], At[m][k], acc[ai][bj][m][n], 0, 0, 0); } __builtin_amdgcn_s_setprio(0); } while (0)
#define PG8_WAIT_V(n) asm volatile("s_waitcnt vmcnt(" #n ")" ::: "memory")
#define PG8_WAIT_L(n) asm volatile("s_waitcnt lgkmcnt(" #n ")" ::: "memory")
#define PG8_BAR __builtin_amdgcn_s_barrier()
#define PG8_SCHED __builtin_amdgcn_sched_barrier(0)
    Unit cur, nxt; int ui = 0;
    if (!S.next(0, cur)) return;
    typedef typename AccSel<I8>::type AccT;
    AccT acc[2][2][4][2];
#pragma unroll
    for (int a = 0; a < 2; ++a)
#pragma unroll
        for (int b = 0; b < 2; ++b)
#pragma unroll
            for (int m = 0; m < 4; ++m)
#pragma unroll
                for (int n = 0; n < 2; ++n) acc[a][b][m][n] = (AccT){0, 0, 0, 0};
    bf16x8 At[4][2], B0[2][2], B1[2][2];
    const char* cA = (const char*)g.A + (size_t)cur.pm * tstep; const char* cB = (const char*)g.Bt + (size_t)cur.pn * tstep + (size_t)(cur.pm / g.pmb) * g.bstep;
    S.a_ready(cur);
    if constexpr (SP2) {
        PG8_STAGE(PG8_SB(0, 0), cB, voffB); PG8_STAGE(PG8_SB(0, 1), cB + hstep, voffB); PG8_STAGE(PG8_SA(0, 0), cA, voffA); PG8_STAGE(PG8_SA(0, 1), cA + hstep, voffA);
        if (wr == 1) PG8_BAR;
        PG8_WAIT_V(2); PG8_BAR;
        PG8_STAGE(PG8_SB(1, 0), cB + kstep, voffB); PG8_STAGE(PG8_SA(1, 0), cA + kstep, voffA); PG8_STAGE(PG8_SB(1, 1), cB + hstep + kstep, voffB);
        PG8_WAIT_V(6); PG8_BAR;
    } else {
        PG8_STAGE(PG8_SB(0, 0), cB, voffB); PG8_STAGE(PG8_SA(0, 0), cA, voffA); PG8_STAGE(PG8_SB(0, 1), cB + hstep, voffB); PG8_STAGE(PG8_SA(0, 1), cA + hstep, voffA);
        if (wr == 1) PG8_BAR;
        PG8_WAIT_V(4); PG8_BAR;
        PG8_STAGE(PG8_SB(1, 0), cB + kstep, voffB); PG8_STAGE(PG8_SA(1, 0), cA + kstep, voffA); PG8_STAGE(PG8_SB(1, 1), cB + hstep + kstep, voffB);
        PG8_WAIT_V(6); PG8_BAR;
    }
    for (;;) {
        const bool has_next = S.next(ui + 1, nxt);
        const char* nA = has_next ? (const char*)g.A + (size_t)nxt.pm * tstep : cA; const char* nB = has_next ? (const char*)g.Bt + (size_t)nxt.pn * tstep + (size_t)(nxt.pm / g.pmb) * g.bstep : cB;
        for (int t = 0; t < nt; t += 2) {
            const bool last = (t == nt - 2);
            const char* a1 = cA + (size_t)(t + 1) * kstep;
            const char* a2 = last ? nA : cA + (size_t)(t + 2) * kstep; const char* b2 = last ? nB : cB + (size_t)(t + 2) * kstep;
            const char* a3 = a2 + kstep; const char* b3 = b2 + kstep;
            if (last && has_next) S.a_ready(nxt);
            if constexpr (SP2) {
            PG8_LDB(B0, 0, 0); PG8_LDB(B1, 0, 1); PG8_SCHED; PG8_LDA(At, 0, 0); PG8_STAGE(PG8_SA(1, 1), a1 + hstep, voffA);
            PG8_WAIT_V(8); PG8_WAIT_L(0); PG8_BAR; PG8_MMA(0, 0, At, B0); PG8_MMA(0, 1, At, B1); PG8_BAR; PG8_SCHED;
            PG8_LDA(At, 0, 1); PG8_STAGE(PG8_SB(0, 0), b2, voffB); PG8_STAGE(PG8_SB(0, 1), b2 + hstep, voffB); PG8_STAGE(PG8_SA(0, 0), a2, voffA);
            PG8_WAIT_V(8); PG8_WAIT_L(0); PG8_BAR; PG8_MMA(1, 0, At, B0); PG8_MMA(1, 1, At, B1); PG8_BAR; PG8_SCHED;
            PG8_LDB(B0, 1, 0); PG8_LDB(B1, 1, 1); PG8_SCHED; PG8_LDA(At, 1, 0); PG8_STAGE(PG8_SA(0, 1), a2 + hstep, voffA);
            PG8_WAIT_V(8); PG8_WAIT_L(0); PG8_BAR; PG8_MMA(0, 0, At, B0); PG8_MMA(0, 1, At, B1); PG8_BAR; PG8_SCHED;
            PG8_LDA(At, 1, 1); PG8_STAGE(PG8_SB(1, 0), b3, voffB); PG8_STAGE(PG8_SB(1, 1), b3 + hstep, voffB); PG8_STAGE(PG8_SA(1, 0), a3, voffA);
            PG8_WAIT_V(8); PG8_WAIT_L(0); PG8_BAR; PG8_MMA(1, 0, At, B0); PG8_MMA(1, 1, At, B1); PG8_BAR; PG8_SCHED;
            } else {
            PG8_LDB(B0, 0, 0); PG8_SCHED; PG8_LDA(At, 0, 0); PG8_STAGE(PG8_SA(1, 1), a1 + hstep, voffA);
            PG8_WAIT_L(8); PG8_BAR; PG8_WAIT_L(0); PG8_MMA(0, 0, At, B0); PG8_BAR; PG8_SCHED;
            PG8_LDB(B1, 0, 1); PG8_STAGE(PG8_SB(0, 0), b2, voffB);
            PG8_BAR; PG8_WAIT_L(0); PG8_MMA(0, 1, At, B1); PG8_BAR;
            PG8_LDA(At, 0, 1); PG8_STAGE(PG8_SA(0, 0), a2, voffA);
            PG8_BAR; PG8_WAIT_L(0); PG8_MMA(1, 0, At, B0); PG8_BAR; PG8_SCHED;
            PG8_STAGE(PG8_SB(0, 1), b2 + hstep, voffB);
            PG8_WAIT_V(6); PG8_BAR; PG8_MMA(1, 1, At, B1); PG8_BAR;
            PG8_LDB(B0, 1, 0); PG8_SCHED; PG8_LDA(At, 1, 0); PG8_STAGE(PG8_SA(0, 1), a2 + hstep, voffA);
            PG8_WAIT_L(8); PG8_BAR; PG8_WAIT_L(0); PG8_MMA(0, 0, At, B0); PG8_BAR; PG8_SCHED;
            PG8_LDB(B1, 1, 1); PG8_STAGE(PG8_SB(1, 0), b3, voffB);
            PG8_BAR; PG8_WAIT_L(0); PG8_MMA(0, 1, At, B1); PG8_BAR;
            PG8_LDA(At, 1, 1); PG8_STAGE(PG8_SA(1, 0), a3, voffA);
            PG8_BAR; PG8_WAIT_L(0); PG8_MMA(1, 0, At, B0); PG8_BAR; PG8_SCHED;
            PG8_STAGE(PG8_SB(1, 1), b3 + hstep, voffB);
            PG8_WAIT_V(6); PG8_BAR; PG8_MMA(1, 1, At, B1); PG8_BAR;
            }
        }
        if constexpr (ALIGN_EPI) { if (wr == 0) PG8_BAR; }
        if constexpr (!Epi::AFTER_DRAIN) { E(acc, cur, wr, wc, fr, fq); S.done(cur); }
        if (!has_next) break;
#pragma unroll
        for (int a = 0; a < 2; ++a)
#pragma unroll
            for (int b = 0; b < 2; ++b)
#pragma unroll
                for (int m = 0; m < 4; ++m)
#pragma unroll
                    for (int n = 0; n < 2; ++n) acc[a][b][m][n] = (AccT){0, 0, 0, 0};
        cur = nxt; cA = nA; cB = nB; ++ui;
        if constexpr (ALIGN_EPI) { if (wr == 1) PG8_BAR; }
    }
    PG8_WAIT_V(0);
    if constexpr (!ALIGN_EPI) { if (wr == 0) PG8_BAR; }
    PG8_BAR;
    if constexpr (Epi::AFTER_DRAIN) { E.fused(acc, cur, wr, wc, fr, fq, lds, wid, lane); S.done(cur); }
#undef PG8_SA
#undef PG8_SB
#undef PG8_STAGE
#undef PG8_LDA
#undef PG8_LDB
#undef PG8_MMA
#undef PG8_WAIT_V
#undef PG8_WAIT_L
#undef PG8_BAR
#undef PG8_SCHED
}
typedef __bf16 bf16x2_t __attribute__((ext_vector_type(2))); typedef float f32x2 __attribute__((ext_vector_type(2)));
__device__ __forceinline__ unsigned pk2(float lo, float hi) { f32x2 v = {lo, hi}; bf16x2_t b = __builtin_convertvector(v, bf16x2_t); return __builtin_bit_cast(unsigned, b); }
__device__ __forceinline__ float silu_f(float v) { return v * __builtin_amdgcn_rcpf(1.0f + __expf(-v)); }
template <bool FUSED> struct EpiSwiGLU {
    static constexpr bool PERM = true, AFTER_DRAIN = false;
    bf16_t* O; const float* rssq; const float* sW; int ldc; int sw_bstride; int rows_per_batch;
    __device__ __forceinline__ void operator()(const f32x4 (&acc)[2][2][4][2], const Unit& u, int wr, int wc, int fr, int fq) const {
        const int row0 = u.pm * BM + wr * 64 + fr, col0 = u.pn * HALF + wc * 32 + 8 * fq;
        f32x4 sg[2], su[2];
        if (FUSED) { const float* sp = sW + (size_t)((u.pm * BM) / rows_per_batch) * sw_bstride + u.pn * BM + wc * 32 + 8 * fq;
            sg[0] = *(const f32x4*)sp; sg[1] = *(const f32x4*)(sp + 4); su[0] = *(const f32x4*)(sp + HALF); su[1] = *(const f32x4*)(sp + HALF + 4); }
#pragma unroll
        for (int ai = 0; ai < 2; ++ai)
#pragma unroll
            for (int m = 0; m < 4; ++m) { bf16_t* rowp = O + (size_t)(row0 + ai * HALF + m * 16) * ldc + col0;
                f32x4 g0 = acc[ai][0][m][0], g1 = acc[ai][0][m][1], u0 = acc[ai][1][m][0], u1 = acc[ai][1][m][1];
                if (FUSED) { const float rs = rsqrtf(rssq[row0 + ai * HALF + m * 16] * (1.f / 1024.f) + 1e-6f); g0 = g0 * rs + sg[0]; g1 = g1 * rs + sg[1]; u0 = u0 * rs + su[0]; u1 = u1 * rs + su[1]; }
                u32x4 w; w.x = pk2(silu_f(g0[0]) * u0[0], silu_f(g0[1]) * u0[1]); w.y = pk2(silu_f(g0[2]) * u0[2], silu_f(g0[3]) * u0[3]);
                w.z = pk2(silu_f(g1[0]) * u1[0], silu_f(g1[1]) * u1[1]); w.w = pk2(silu_f(g1[2]) * u1[2], silu_f(g1[3]) * u1[3]);
                *(u32x4*)rowp = w; }
    }
};
struct EpiSwiGLUq {
    static constexpr bool PERM = true, AFTER_DRAIN = false;
    bf16_t* O; const float* rowscale; const float* colscale; int ldc;
    __device__ __forceinline__ void operator()(const i32x4 (&acc)[2][2][4][2], const Unit& u, int wr, int wc, int fr, int fq) const {
        const int row0 = u.pm * BM + wr * 64 + fr, col0 = u.pn * HALF + wc * 32 + 8 * fq;
        const float* sp = colscale + u.pn * BM + wc * 32 + 8 * fq;
        const f32x4 sg0 = *(const f32x4*)sp, sg1 = *(const f32x4*)(sp + 4), su0 = *(const f32x4*)(sp + HALF), su1 = *(const f32x4*)(sp + HALF + 4);
#pragma unroll
        for (int ai = 0; ai < 2; ++ai)
#pragma unroll
            for (int m = 0; m < 4; ++m) { bf16_t* rowp = O + (size_t)(row0 + ai * HALF + m * 16) * ldc + col0;
                const float rs = rowscale[row0 + ai * HALF + m * 16];
                const f32x4 g0 = __builtin_convertvector(acc[ai][0][m][0], f32x4) * (sg0 * rs), g1 = __builtin_convertvector(acc[ai][0][m][1], f32x4) * (sg1 * rs);
                const f32x4 u0 = __builtin_convertvector(acc[ai][1][m][0], f32x4) * (su0 * rs), u1 = __builtin_convertvector(acc[ai][1][m][1], f32x4) * (su1 * rs);
                u32x4 w; w.x = pk2(silu_f(g0[0]) * u0[0], silu_f(g0[1]) * u0[1]); w.y = pk2(silu_f(g0[2]) * u0[2], silu_f(g0[3]) * u0[3]);
                w.z = pk2(silu_f(g1[0]) * u1[0], silu_f(g1[1]) * u1[1]); w.w = pk2(silu_f(g1[2]) * u1[2], silu_f(g1[3]) * u1[3]);
                *(u32x4*)rowp = w; }
    }
};
template <bool BASE_BF16, bool OUT_BF16, bool RS = false, bool SSQ = false> struct EpiResid {
    static constexpr bool PERM = true, AFTER_DRAIN = false;
    const void* base; void* out; const float* gate; const float* rssq; float* ossq; int ldc; int gate_bstride; int rows_per_batch; float coef; float rs_inv_n;
    __device__ __forceinline__ void operator()(const f32x4 (&acc)[2][2][4][2], const Unit& u, int wr, int wc, int fr, int fq) const {
        const int row0 = u.pm * BM + wr * 64 + fr, col0 = u.pn * BM + wc * 32 + 8 * fq;
        const float* gp = gate + (size_t)((u.pm * BM) / rows_per_batch) * gate_bstride + col0;
        f32x4 gv[2][2];
#pragma unroll
        for (int bj = 0; bj < 2; ++bj)
#pragma unroll
            for (int n = 0; n < 2; ++n) gv[bj][n] = (*(const f32x4*)(gp + bj * HALF + n * 4) + 1.0f) * coef;
        constexpr int GB = BASE_BF16 ? 4 : 2;
#pragma unroll
        for (int gb = 0; gb < 8; gb += GB) {
            u32x4 braw[GB][2][BASE_BF16 ? 1 : 2];
#pragma unroll
            for (int q = 0; q < GB; ++q) { const int ai = (gb + q) >> 2, m = (gb + q) & 3; const size_t off = (size_t)(row0 + ai * HALF + m * 16) * ldc + col0;
#pragma unroll
                for (int bj = 0; bj < 2; ++bj) {
                    if (BASE_BF16) braw[q][bj][0] = *(const u32x4*)((const bf16_t*)base + off + bj * HALF);
                    else { braw[q][bj][0] = *(const u32x4*)((const float*)base + off + bj * HALF); braw[q][bj][BASE_BF16 ? 0 : 1] = *(const u32x4*)((const float*)base + off + bj * HALF + 4); } } }
#pragma unroll
            for (int q = 0; q < GB; ++q) { const int ai = (gb + q) >> 2, m = (gb + q) & 3; const size_t off = (size_t)(row0 + ai * HALF + m * 16) * ldc + col0;
                float rsc = 1.0f; if (RS) rsc = rsqrtf(rssq[row0 + ai * HALF + m * 16] * rs_inv_n + 1e-6f);
                float sq = 0.f;
#pragma unroll
                for (int bj = 0; bj < 2; ++bj) {
                    f32x4 b0, b1;
                    if (BASE_BF16) { const u32x4 w = braw[q][bj][0];
                        b0 = (f32x4){__uint_as_float(w.x << 16), __uint_as_float(w.x & 0xffff0000u), __uint_as_float(w.y << 16), __uint_as_float(w.y & 0xffff0000u)};
                        b1 = (f32x4){__uint_as_float(w.z << 16), __uint_as_float(w.z & 0xffff0000u), __uint_as_float(w.w << 16), __uint_as_float(w.w & 0xffff0000u)}; }
                    else { b0 = __builtin_bit_cast(f32x4, braw[q][bj][0]); b1 = __builtin_bit_cast(f32x4, braw[q][bj][BASE_BF16 ? 0 : 1]); }
                    f32x4 a0 = acc[ai][bj][m][0], a1 = acc[ai][bj][m][1]; if (RS) { a0 = a0 * rsc; a1 = a1 * rsc; }
                    const f32x4 o0 = b0 + a0 * gv[bj][0], o1 = b1 + a1 * gv[bj][1];
                    if (SSQ) sq += (o0[0] * o0[0] + o0[1] * o0[1]) + (o0[2] * o0[2] + o0[3] * o0[3]) + (o1[0] * o1[0] + o1[1] * o1[1]) + (o1[2] * o1[2] + o1[3] * o1[3]);
                    if (OUT_BF16) { u32x4 w; w.x = pk2(o0[0], o0[1]); w.y = pk2(o0[2], o0[3]); w.z = pk2(o1[0], o1[1]); w.w = pk2(o1[2], o1[3]); *(u32x4*)((bf16_t*)out + off + bj * HALF) = w; }
                    else { *(f32x4*)((float*)out + off + bj * HALF) = o0; *(f32x4*)((float*)out + off + bj * HALF + 4) = o1; }
                }
                if (SSQ) { sq += __shfl_xor(sq, 16); sq += __shfl_xor(sq, 32); if (fq == 0) __hip_atomic_fetch_add(ossq + row0 + ai * HALF + m * 16, sq, __ATOMIC_RELAXED, __HIP_MEMORY_SCOPE_AGENT); }
            }
            asm volatile("" ::: "memory");
        }
    }
};
struct EpiProj {
    static constexpr bool PERM = true, AFTER_DRAIN = false;
    bf16_t* O; float* DT; const float* dt_bias; const float* rssq; const float* sW; int ldc; int nfull; int sw_bstride; int rows_per_batch;
    __device__ __forceinline__ void operator()(const f32x4 (&acc)[2][2][4][2], const Unit& u, int wr, int wc, int fr, int fq) const {
        const int row0 = u.pm * BM + wr * 64 + fr;
        const float* sp = sW + (size_t)((u.pm * BM) / rows_per_batch) * sw_bstride + u.pn * BM + wc * 32 + 8 * fq;
        if (u.pn < nfull) {
            const int col0 = u.pn * BM + wc * 32 + 8 * fq;
            f32x4 sv[2][2];
#pragma unroll
            for (int bj = 0; bj < 2; ++bj) { sv[bj][0] = *(const f32x4*)(sp + bj * HALF); sv[bj][1] = *(const f32x4*)(sp + bj * HALF + 4); }
#pragma unroll
            for (int ai = 0; ai < 2; ++ai)
#pragma unroll
                for (int m = 0; m < 4; ++m) { bf16_t* rowp = O + (size_t)(row0 + ai * HALF + m * 16) * ldc + col0;
                    const float rs = rsqrtf(rssq[row0 + ai * HALF + m * 16] * (1.f / 1024.f) + 1e-6f);
#pragma unroll
                    for (int bj = 0; bj < 2; ++bj) { const f32x4 v0 = acc[ai][bj][m][0] * rs + sv[bj][0], v1 = acc[ai][bj][m][1] * rs + sv[bj][1];
                        u32x4 w; w.x = pk2(v0[0], v0[1]); w.y = pk2(v0[2], v0[3]); w.z = pk2(v1[0], v1[1]); w.w = pk2(v1[2], v1[3]);
                        *(u32x4*)(rowp + bj * HALF) = w; } }
        } else if (wc == 0 && fq < 2) {
            const f32x4 b0 = *(const f32x4*)(dt_bias + 8 * fq) + *(const f32x4*)sp, b1 = *(const f32x4*)(dt_bias + 8 * fq + 4) + *(const f32x4*)(sp + 4);
#pragma unroll
            for (int ai = 0; ai < 2; ++ai)
#pragma unroll
                for (int m = 0; m < 4; ++m) { float* rowp = DT + (size_t)(row0 + ai * HALF + m * 16) * 16 + 8 * fq;
                    const float rs = rsqrtf(rssq[row0 + ai * HALF + m * 16] * (1.f / 1024.f) + 1e-6f);
                    f32x4 v0 = acc[ai][0][m][0] * rs + b0, v1 = acc[ai][0][m][1] * rs + b1;
#pragma unroll
                    for (int j = 0; j < 4; ++j) { v0[j] = v0[j] > 20.f ? v0[j] : log1pf(__expf(v0[j])); v1[j] = v1[j] > 20.f ? v1[j] : log1pf(__expf(v1[j])); }
                    *(f32x4*)rowp = v0; *(f32x4*)(rowp + 4) = v1; }
        }
    }
};
struct EpiNull { static constexpr bool PERM = true, AFTER_DRAIN = false; float* sink;
    __device__ __forceinline__ void operator()(const f32x4 (&acc)[2][2][4][2], const Unit& u, int wr, int wc, int fr, int fq) const {
        f32x4 s = {0.f, 0.f, 0.f, 0.f};
#pragma unroll
        for (int ai = 0; ai < 2; ++ai)
#pragma unroll
            for (int bj = 0; bj < 2; ++bj)
#pragma unroll
                for (int m = 0; m < 4; ++m)
#pragma unroll
                    for (int n = 0; n < 2; ++n) s += acc[ai][bj][m][n];
        if (s[0] + s[1] + s[2] + s[3] == 123.456f) sink[0] = s[0]; }
};
}
#define GAS __attribute__((address_space(1)))
#define LAS __attribute__((address_space(3)))
typedef unsigned short bf16;
typedef unsigned v4u __attribute__((ext_vector_type(4)));
typedef unsigned v2u __attribute__((ext_vector_type(2)));
typedef float f32x4 __attribute__((ext_vector_type(4)));
typedef float f32x16 __attribute__((ext_vector_type(16)));
typedef short bf16x8 __attribute__((ext_vector_type(8)));
typedef short s16x4 __attribute__((ext_vector_type(4)));
typedef short v4i16_t __attribute__((ext_vector_type(4)));
using pg8::pk2; using pg8::silu_f;

constexpr int NWAVES = 8, NTHR = 512;
constexpr int D = 1024, BATCH = 4, SEQ = 8192, M = BATCH * SEQ;
constexpr int DFF = 2816, NGU = 2 * DFF;
constexpr int NPROJ = 2304, NPROJ_PAD = 2560, IN_WIDTH = 2320;
constexpr int PZ = 0, PXBC = 512, PQ = 1536, PK = 2048, PV = 2176;
constexpr int NCHUNK = 64, CH = 128;
constexpr int NMOD = 9 * D;
constexpr float EPS = 1e-6f;
constexpr float LOG2E = 1.4426950408889634f;
constexpr float QSCALE = 0.125f * LOG2E;

constexpr size_t MiB = 1u << 20;
constexpr size_t WS_CTL = 0, CTL_ZERO_BYTES = 1 * MiB;
constexpr size_t CTL_MOD = 65536, CTL_BAR = 16384, CTL_SSQ = 262144, CTL_RSSQ1 = 393216, CTL_RSSQ2 = 524288, CTL_SW2 = 655360, CTL_SW3 = 720896;
constexpr size_t CTL_ROWSC = 720896, CTL_CMAX = 860160, CTL_COLSC = 917504;
constexpr size_t WS_WGU1 = 2 * MiB, WS_WD1 = 13 * MiB, WS_WIN = 19 * MiB, WS_WOUT = 24 * MiB, WS_WGU2 = 26 * MiB, WS_WD2 = 37 * MiB;
constexpr size_t WS_DT = 43 * MiB, WS_CD = 45 * MiB;
constexpr size_t WS_U = 48 * MiB;
constexpr size_t WS_H = 112 * MiB;
constexpr size_t WS_WINB = 288 * MiB;
constexpr size_t WS_WGU2B = 308 * MiB;
constexpr size_t WS_X1 = 416 * MiB;
constexpr size_t WS_END = 480 * MiB;

constexpr int XS_PITCH = 528, BS_PITCH = 272, KV_PITCH = 144;
constexpr int L_XS = 0, L_BS = 128 * XS_PITCH, L_CS = L_BS + 128 * BS_PITCH, L_ARR = L_CS + 128 * BS_PITCH, L_END = L_ARR + 8192;
constexpr int LDS_BYTES = 152 * 1024;
static_assert(L_END + 64 <= LDS_BYTES && pg8::STAGE_BYTES <= LDS_BYTES, "LDS map");

struct Frame { LAS unsigned char* lds; int tid, lane, wave, vcu, G; };

__device__ __forceinline__ float bf_lo(unsigned w) { return __uint_as_float(w << 16); }
__device__ __forceinline__ float bf_hi(unsigned w) { return __uint_as_float(w & 0xffff0000u); }
__device__ __forceinline__ float wave_sum(float v) {
#pragma unroll
    for (int o = 1; o < 64; o <<= 1) v += __shfl_xor(v, o);
    return v;
}
#define LDS_WAIT() asm volatile("s_waitcnt lgkmcnt(0)" ::: "memory")
__device__ __forceinline__ f32x16 mfma32(bf16x8 a, bf16x8 b, f32x16 c) { return __builtin_amdgcn_mfma_f32_32x32x16_bf16(a, b, c, 0, 0, 0); }
__device__ __forceinline__ int crow(int reg, int h) { return (reg & 3) + 8 * (reg >> 2) + 4 * h; }
__device__ __forceinline__ bf16x8 frag_row(const LAS unsigned char* base, int pitch, int mn0, int k0, int lane) {
    return *(const LAS bf16x8*)(base + (mn0 + (lane & 31)) * pitch + (k0 + 8 * (lane >> 5)) * 2);
}
__device__ __forceinline__ s16x4 ds_tr(const LAS unsigned char* p) { return __builtin_bit_cast(s16x4, __builtin_amdgcn_ds_read_tr16_b64_v4i16((LAS v4i16_t*)p)); }
__device__ __forceinline__ bf16x8 frag_tr(const LAS unsigned char* base, int pitch, int kA, int kB, int mn0, int lane) {
    const int q4 = (lane & 15) >> 2, cb = (mn0 + 16 * ((lane >> 4) & 1) + 4 * (lane & 3)) * 2;
    const s16x4 a = ds_tr(base + (kA + q4) * pitch + cb), b = ds_tr(base + (kB + q4) * pitch + cb);
    bf16x8 r; r[0] = a[0]; r[1] = a[1]; r[2] = a[2]; r[3] = a[3]; r[4] = b[0]; r[5] = b[1]; r[6] = b[2]; r[7] = b[3]; return r;
}
__device__ __forceinline__ int perm_row(int m, int t) { return 32 * ((m >> 2) & 1) + 16 * t + 4 * (m >> 3) + (m & 3); }
__device__ __forceinline__ bf16x8 frag_tr_perm(const LAS unsigned char* base, int pitch, int kA, int kB, int mn_base, int t, int lane) {
    const int q4 = (lane & 15) >> 2, cb = (mn_base + 32 * (lane & 1) + 16 * t + 8 * ((lane >> 4) & 1) + 4 * ((lane >> 1) & 1)) * 2;
    const s16x4 a = ds_tr(base + (kA + q4) * pitch + cb), b2 = ds_tr(base + (kB + q4) * pitch + cb);
    bf16x8 r; r[0] = a[0]; r[1] = a[1]; r[2] = a[2]; r[3] = a[3]; r[4] = b2[0]; r[5] = b2[1]; r[6] = b2[2]; r[7] = b2[3]; return r;
}
__device__ __forceinline__ bf16x8 pack_step(const f32x16& x, int s) {
    v4u p; p.x = pk2(x[8 * s], x[8 * s + 1]); p.y = pk2(x[8 * s + 2], x[8 * s + 3]); p.z = pk2(x[8 * s + 4], x[8 * s + 5]); p.w = pk2(x[8 * s + 6], x[8 * s + 7]);
    return __builtin_bit_cast(bf16x8, p);
}

template <int MAP> __device__ __forceinline__ int map_row(int n) {
    if (MAP == 1) return 256 * (n >> 7) + (n & 127);
    if (MAP == 2) return 256 * (n >> 7) + 128 + (n & 127);
    if (MAP == 3) { if (n < 1536) return n; if (n < 1552) return NPROJ + (n - 1536); return n - 16; }
    return n;
}
template <int MAP>
__device__ __forceinline__ void transpose_item(const float* W, int K, int N, bf16* WT, LAS float* scr, int item, int lane) {
    const int nblk = (N + 31) / 32, kb = item / nblk, nb = item % nblk, k0 = 64 * kb, n0 = 32 * nb;
    const int nn = n0 + (lane & 31);
#pragma unroll
    for (int i = 0; i < 32; ++i) { const int kk = 2 * i + (lane >> 5); scr[kk * 33 + (lane & 31)] = nn < N ? W[(size_t)(k0 + kk) * N + nn] : 0.f; }
    LDS_WAIT(); asm volatile("" ::: "memory");
    const int c = lane & 7;
#pragma unroll
    for (int j = 0; j < 4; ++j) { const int n = (lane >> 3) + 8 * j; const LAS float* s = scr + (8 * c) * 33 + n;
        v4u o; o.x = pk2(s[0 * 33], s[1 * 33]); o.y = pk2(s[2 * 33], s[3 * 33]); o.z = pk2(s[4 * 33], s[5 * 33]); o.w = pk2(s[6 * 33], s[7 * 33]);
        if (n0 + n < N) *(v4u*)(WT + (size_t)map_row<MAP>(n0 + n) * K + k0 + 8 * c) = o; }
    LDS_WAIT(); asm volatile("" ::: "memory");
}
struct P0Args { const float *wg1, *wu1, *wd1, *wout, *wd2, *c, *wada, *bada, *wg2, *wu2; bf16 *WGU1, *WD1, *WOUT, *WD2; float* mod; unsigned* cmax; };
__device__ __forceinline__ void p0_prologue(const Frame& F, const P0Args& A) {
    LAS float* scr = (LAS float*)(F.lds + F.wave * 16384);
    const int gw = F.vcu * NWAVES + F.wave, NGW = F.G * NWAVES;
    constexpr int I_D = (DFF / 64) * (D / 32), I_O = (D / 64) * (D / 32);
    constexpr int NITEMS = 2 * I_D + I_O;
    for (int it = gw; it < NITEMS; it += NGW) {
        int r = it;
        if (r < I_D)  { transpose_item<0>(A.wd1, DFF, D, A.WD1, scr, r, F.lane); continue; } r -= I_D;
        if (r < I_D)  { transpose_item<0>(A.wd2, DFF, D, A.WD2, scr, r, F.lane); continue; } r -= I_D;
        transpose_item<0>(A.wout, D, D, A.WOUT, scr, r, F.lane);
    }
    { constexpr int NCGW = DFF / 64, NKSW = D / 64;
      for (int it = gw; it < 4 * NCGW * NKSW; it += NGW) {
          const int mat = it / (NCGW * NKSW), rr = it % (NCGW * NKSW), cgp = rr % NCGW, ks = rr / NCGW, n = cgp * 64 + F.lane;
          const float* W = mat == 0 ? A.wg1 : mat == 1 ? A.wu1 : mat == 2 ? A.wg2 : A.wu2;
          const float* wp = W + (size_t)(ks * 64) * DFF + n;
          float mx = 0.f;
#pragma unroll 32
          for (int kk = 0; kk < 64; ++kk) mx = fmaxf(mx, fabsf(wp[(size_t)kk * DFF]));
          const int prow = (mat & 1) ? map_row<2>(n) : map_row<1>(n);
          atomicMax(A.cmax + (mat >> 1) * NGU + prow, __float_as_uint(mx)); } }
    constexpr int NCG = NMOD / 64, NKS = D / 64;
    for (int it = gw; it < NCG * NKS; it += NGW) {
        const int cgp = it % NCG, ks = it / NCG, n = cgp * 64 + F.lane, k0 = ks * 64;
        float s[4], acc[4] = {0.f, 0.f, 0.f, 0.f};
#pragma unroll
        for (int b = 0; b < 4; ++b) s[b] = silu_f(A.c[b * D + k0 + F.lane]);
        const float* wp = A.wada + (size_t)k0 * NMOD + n;
#pragma unroll 32
        for (int kk = 0; kk < 64; ++kk) { const float w = wp[(size_t)kk * NMOD];
#pragma unroll
            for (int b = 0; b < 4; ++b) acc[b] += w * __uint_as_float(__builtin_amdgcn_readlane(__float_as_uint(s[b]), kk)); }
        const float bias = ks == 0 ? A.bada[n] : 0.f;
#pragma unroll
        for (int b = 0; b < 4; ++b) __hip_atomic_fetch_add(A.mod + b * NMOD + n, acc[b] + bias, __ATOMIC_RELAXED, __HIP_MEMORY_SCOPE_AGENT);
    }
}

template <int MAP>
__device__ __forceinline__ void quant_item(const float* W, int K, int N, signed char* WQ, const unsigned* cmax, float* colscale, LAS float* scr, int item, int lane) {
    const int nblk = (N + 31) / 32, kb = item / nblk, nb = item % nblk, k0 = 64 * kb, n0 = 32 * nb;
    const int nn = n0 + (lane & 31);
#pragma unroll
    for (int i = 0; i < 32; ++i) { const int kk = 2 * i + (lane >> 5); scr[kk * 33 + (lane & 31)] = nn < N ? W[(size_t)(k0 + kk) * N + nn] : 0.f; }
    LDS_WAIT(); asm volatile("" ::: "memory");
    const int c = lane & 7;
#pragma unroll
    for (int j = 0; j < 4; ++j) { const int n = (lane >> 3) + 8 * j; const LAS float* s = scr + (8 * c) * 33 + n;
        const int prow = map_row<MAP>(n0 + n);
        const float cm = fmaxf(__uint_as_float(cmax[prow]), 1e-30f), inv = 127.0f / cm;
        unsigned lo = 0u, hi = 0u;
#pragma unroll
        for (int jj = 0; jj < 4; ++jj) { lo |= ((unsigned)((int)rintf(s[jj * 33] * inv)) & 0xffu) << (8 * jj); hi |= ((unsigned)((int)rintf(s[(jj + 4) * 33] * inv)) & 0xffu) << (8 * jj); }
        v2u o; o.x = lo; o.y = hi;
        if (n0 + n < N) { *(v2u*)(WQ + (size_t)prow * K + k0 + 8 * c) = o; if (kb == 0 && c == 0) colscale[prow] = cm * (1.0f / 127.0f); } }
    LDS_WAIT(); asm volatile("" ::: "memory");
}

template <int MAP>
__device__ __forceinline__ void scale_item(const float* W, int K, int N, bf16* WB, size_t copy_stride, const float* gain, const float* mod, int i_shift, int i_scale, float* sW, int sw_stride, LAS float* scr, int item, int lane) {
    const int nblk = (N + 31) / 32, kb = item / nblk, nb = item % nblk, k0 = 64 * kb, n0 = 32 * nb;
    const int nn = n0 + (lane & 31);
#pragma unroll
    for (int i = 0; i < 32; ++i) { const int kk = 2 * i + (lane >> 5); scr[kk * 33 + (lane & 31)] = nn < N ? W[(size_t)(k0 + kk) * N + nn] : 0.f; }
    float gsv[4], shv[4];
    { const float gn = gain[k0 + lane];
#pragma unroll
      for (int b = 0; b < 4; ++b) { gsv[b] = gn * (1.0f + mod[b * NMOD + i_scale * D + k0 + lane]); shv[b] = mod[b * NMOD + i_shift * D + k0 + lane]; } }
    LDS_WAIT(); asm volatile("" ::: "memory");
    { float acc[4] = {0.f, 0.f, 0.f, 0.f};
#pragma unroll 16
      for (int kk = 0; kk < 64; ++kk) { const float w = scr[kk * 33 + (lane & 31)];
#pragma unroll
          for (int b = 0; b < 4; ++b) acc[b] += w * __uint_as_float(__builtin_amdgcn_readlane(__float_as_uint(shv[b]), kk)); }
      if (lane < 32 && nn < N) {
#pragma unroll
          for (int b = 0; b < 4; ++b) __hip_atomic_fetch_add(sW + b * sw_stride + map_row<MAP>(nn), acc[b], __ATOMIC_RELAXED, __HIP_MEMORY_SCOPE_AGENT); } }
    const int c = lane & 7;
#pragma unroll
    for (int b = 0; b < 4; ++b) {
        float gk[8];
#pragma unroll
        for (int jj = 0; jj < 8; ++jj) gk[jj] = __shfl(gsv[b], 8 * c + jj);
#pragma unroll
        for (int j = 0; j < 4; ++j) { const int n = (lane >> 3) + 8 * j; const LAS float* s = scr + (8 * c) * 33 + n;
            v4u o; o.x = pk2(s[0 * 33] * gk[0], s[1 * 33] * gk[1]); o.y = pk2(s[2 * 33] * gk[2], s[3 * 33] * gk[3]); o.z = pk2(s[4 * 33] * gk[4], s[5 * 33] * gk[5]); o.w = pk2(s[6 * 33] * gk[6], s[7 * 33] * gk[7]);
            if (n0 + n < N) *(v4u*)(WB + b * copy_stride + (size_t)map_row<MAP>(n0 + n) * K + k0 + 8 * c) = o; }
    }
    LDS_WAIT(); asm volatile("" ::: "memory");
}
struct PrepArgs { const float *win, *wg1, *wu1, *wg2, *wu2, *gain2, *mod; bf16* WINB; float* sW2; signed char *WGU1Q, *WGU2Q; const unsigned* cmax; float* colscale; };
__device__ __forceinline__ void prep_phase(const Frame& F, const PrepArgs& A) {
    LAS float* scr = (LAS float*)(F.lds + F.wave * 16384);
    const int gw = F.vcu * NWAVES + F.wave, NGW = F.G * NWAVES;
    constexpr int I_GU = (D / 64) * (DFF / 32), I_IN = (D / 64) * ((IN_WIDTH + 31) / 32);
    for (int it = gw; it < 4 * I_GU + I_IN; it += NGW) {
        int r = it;
        if (r < I_IN) { scale_item<3>(A.win, D, IN_WIDTH, A.WINB, (size_t)NPROJ_PAD * D, A.gain2, A.mod, 3, 4, A.sW2, NPROJ_PAD, scr, r, F.lane); continue; } r -= I_IN;
        if (r < I_GU) { quant_item<1>(A.wg1, D, DFF, A.WGU1Q, A.cmax, A.colscale, scr, r, F.lane); continue; } r -= I_GU;
        if (r < I_GU) { quant_item<2>(A.wu1, D, DFF, A.WGU1Q, A.cmax, A.colscale, scr, r, F.lane); continue; } r -= I_GU;
        if (r < I_GU) { quant_item<1>(A.wg2, D, DFF, A.WGU2Q, A.cmax + NGU, A.colscale + NGU, scr, r, F.lane); continue; } r -= I_GU;
        quant_item<2>(A.wu2, D, DFF, A.WGU2Q, A.cmax + NGU, A.colscale + NGU, scr, r, F.lane);
    }
    { const int gt = (F.vcu * NTHR + F.tid), NT = F.G * NTHR; v4u z = {0u, 0u, 0u, 0u}; constexpr int PER = (NPROJ_PAD - IN_WIDTH) * D / 8;
      for (int i = gt; i < 4 * PER; i += NT) { const int b = i / PER, j = i % PER; *(v4u*)(A.WINB + (size_t)b * NPROJ_PAD * D + (size_t)IN_WIDTH * D + (size_t)j * 8) = z; } }
}

template <bool IN_BF16>
__device__ __forceinline__ void norm_q_phase(const Frame& F, const void* xin_, const float* gain, const float* mod, int i_shift, int i_scale, signed char* Uq, float* rowscale) {
    const int gw = F.vcu * NWAVES + F.wave, NGW = F.G * NWAVES;
    for (int m0 = gw * 16; m0 < M; m0 += NGW * 16) {
        const int b = m0 / SEQ;
        f32x4 gs[4], sh[4];
#pragma unroll
        for (int j = 0; j < 4; ++j) { const int col = 4 * F.lane + 256 * j;
            const f32x4 g = *(const f32x4*)(gain + col), sc = *(const f32x4*)(mod + b * NMOD + i_scale * D + col);
            gs[j] = g * (sc + 1.0f); sh[j] = *(const f32x4*)(mod + b * NMOD + i_shift * D + col); }
        for (int r = 0; r < 16; ++r) {
            f32x4 v[4]; float s = 0.f;
            if (IN_BF16) { const v2u* xr = (const v2u*)((const bf16*)xin_ + (size_t)(m0 + r) * D) + F.lane;
#pragma unroll
                for (int j = 0; j < 4; ++j) { const v2u w = xr[64 * j]; v[j] = (f32x4){bf_lo(w.x), bf_hi(w.x), bf_lo(w.y), bf_hi(w.y)}; } }
            else { const f32x4* xr = (const f32x4*)((const float*)xin_ + (size_t)(m0 + r) * D) + F.lane;
#pragma unroll
                for (int j = 0; j < 4; ++j) v[j] = xr[64 * j]; }
#pragma unroll
            for (int j = 0; j < 4; ++j) s += (v[j].x * v[j].x + v[j].y * v[j].y) + (v[j].z * v[j].z + v[j].w * v[j].w);
            const float rstd = rsqrtf(wave_sum(s) * (1.f / D) + EPS);
            float mx = 0.f;
#pragma unroll
            for (int j = 0; j < 4; ++j) { v[j] = v[j] * rstd * gs[j] + sh[j]; mx = fmaxf(mx, fmaxf(fmaxf(fabsf(v[j].x), fabsf(v[j].y)), fmaxf(fabsf(v[j].z), fabsf(v[j].w)))); }
#pragma unroll
            for (int o = 1; o < 64; o <<= 1) mx = fmaxf(mx, __shfl_xor(mx, o));
            mx = fmaxf(mx, 1e-30f);
            const float inv = 127.0f / mx;
            unsigned* o4 = (unsigned*)(Uq + (size_t)(m0 + r) * D) + F.lane;
#pragma unroll
            for (int j = 0; j < 4; ++j) { const unsigned w = ((unsigned)((int)rintf(v[j].x * inv)) & 0xffu) | (((unsigned)((int)rintf(v[j].y * inv)) & 0xffu) << 8) | (((unsigned)((int)rintf(v[j].z * inv)) & 0xffu) << 16) | (((unsigned)((int)rintf(v[j].w * inv)) & 0xffu) << 24);
                o4[64 * j] = w; }
            if (F.lane == 0) rowscale[m0 + r] = mx * (1.0f / 127.0f);
        }
    }
}

template <bool IN_BF16>
__device__ __forceinline__ void norm_phase(const Frame& F, const void* xin_, const float* gain, const float* mod, int i_shift, int i_scale, bf16* U) {
    const int gw = F.vcu * NWAVES + F.wave, NGW = F.G * NWAVES;
    for (int m0 = gw * 16; m0 < M; m0 += NGW * 16) {
        const int b = m0 / SEQ;
        f32x4 gs[4], sh[4];
#pragma unroll
        for (int j = 0; j < 4; ++j) { const int col = 4 * F.lane + 256 * j;
            const f32x4 g = *(const f32x4*)(gain + col), sc = *(const f32x4*)(mod + b * NMOD + i_scale * D + col);
            gs[j] = g * (sc + 1.0f); sh[j] = *(const f32x4*)(mod + b * NMOD + i_shift * D + col); }
        for (int r = 0; r < 16; ++r) {
            f32x4 v[4]; float s = 0.f;
            if (IN_BF16) { const v2u* xr = (const v2u*)((const bf16*)xin_ + (size_t)(m0 + r) * D) + F.lane;
#pragma unroll
                for (int j = 0; j < 4; ++j) { const v2u w = xr[64 * j]; v[j] = (f32x4){bf_lo(w.x), bf_hi(w.x), bf_lo(w.y), bf_hi(w.y)}; } }
            else { const f32x4* xr = (const f32x4*)((const float*)xin_ + (size_t)(m0 + r) * D) + F.lane;
#pragma unroll
                for (int j = 0; j < 4; ++j) v[j] = xr[64 * j]; }
#pragma unroll
            for (int j = 0; j < 4; ++j) s += (v[j].x * v[j].x + v[j].y * v[j].y) + (v[j].z * v[j].z + v[j].w * v[j].w);
            const float rstd = rsqrtf(wave_sum(s) * (1.f / D) + EPS);
            v2u* o8 = (v2u*)(U + (size_t)(m0 + r) * D) + F.lane;
#pragma unroll
            for (int j = 0; j < 4; ++j) { const f32x4 o = v[j] * rstd * gs[j] + sh[j]; v2u w; w.x = pk2(o.x, o.y); w.y = pk2(o.z, o.w); o8[64 * j] = w; }
        }
    }
}
typedef GAS unsigned gu32;
#define RLX_AGENT __ATOMIC_RELAXED, __HIP_MEMORY_SCOPE_AGENT
#define XB_TMO      128
#define XB_XCNT(j)  (256  + 64 * (j))
#define XB_XSUB(j)  (1280 + 64 * (j))
#define XB_XGEN(j)  (2304 + 64 * (j))
#define XB_TOP      3328
#define XB_TOPGEN   3392
#define XCD_BAR_WORDS 3456
#define XB_SPIN_CAP (1u << 18)

__device__ __forceinline__ unsigned xb_ld(unsigned* p)              { return __hip_atomic_load(p, __ATOMIC_RELAXED, __HIP_MEMORY_SCOPE_AGENT); }
__device__ __forceinline__ unsigned xb_add(unsigned* p, unsigned v) { return __hip_atomic_fetch_add(p, v, __ATOMIC_RELAXED, __HIP_MEMORY_SCOPE_AGENT); }
__device__ __forceinline__ unsigned xb_xcc_id() { return (unsigned)__builtin_amdgcn_s_getreg((3 << 11) | 20) & 0xFu; }
#define XB_SPIN(cond, bar) do { unsigned _sp = 0; while (cond) { __builtin_amdgcn_s_sleep(1); \
    if ((++_sp & 255u) == 0u) { if (xb_ld(&(bar)[XB_TMO])) break; if (_sp > XB_SPIN_CAP) { atomicAdd(&(bar)[XB_TMO], 1u); break; } } } } while (0)

struct XcdBarrier {
    unsigned* bar; unsigned x;
    volatile LAS unsigned* st;
};

__device__ __forceinline__ XcdBarrier xcd_barrier_post(unsigned* bar, volatile LAS unsigned* st) {
    XcdBarrier b; b.bar = bar; b.x = xb_xcc_id(); b.st = st;
    if (threadIdx.x == 0) (void)xb_add(&bar[XB_XCNT(b.x)], 1u);
    return b;
}
__device__ __forceinline__ void xcd_barrier_complete(unsigned* bar, unsigned x, unsigned& nloc, unsigned& nx) {
    const unsigned G = gridDim.x * gridDim.y * gridDim.z;
    unsigned sum, cnt, mine, sp = 0u;
    for (;;) {
        sum = 0u; cnt = 0u; mine = 0u;
#pragma unroll
        for (unsigned j = 0; j < 16; ++j) { const unsigned c = xb_ld(&bar[XB_XCNT(j)]); sum += c; cnt += (c > 0u) ? 1u : 0u; mine = (j == x) ? c : mine; }
        if (sum == G) break;
        __builtin_amdgcn_s_sleep(1);
        if ((++sp & 255u) == 0u) { if (xb_ld(&bar[XB_TMO])) break; if (sp > XB_SPIN_CAP) { atomicAdd(&bar[XB_TMO], 1u); break; } }
    }
    nloc = mine > 0u ? mine : 1u; nx = cnt > 0u ? cnt : 1u;
}

__device__ __forceinline__ void xcd_barrier(const XcdBarrier& b) {
    asm volatile("s_waitcnt vmcnt(0)" ::: "memory");
    __syncthreads();
    if (threadIdx.x == 0) {
        unsigned* bar = b.bar;
        __builtin_amdgcn_s_waitcnt(0);
        unsigned nloc = b.st[0], nx = b.st[1];
        if (nloc == 0u) { xcd_barrier_complete(bar, b.x, nloc, nx); b.st[0] = nloc; b.st[1] = nx; }
        const unsigned old = xb_add(&bar[XB_XSUB(b.x)], 1u);
        const unsigned gen = old / nloc;
        if (old + 1u == (gen + 1u) * nloc) {
            __builtin_amdgcn_fence(__ATOMIC_RELEASE, "agent");
            asm volatile("s_waitcnt vmcnt(0)" ::: "memory");
            const unsigned og = xb_add(&bar[XB_TOP], 1u);
            const unsigned tg = og / nx;
            if (og + 1u == (tg + 1u) * nx) xb_add(&bar[XB_TOPGEN], 1u);
            else XB_SPIN(xb_ld(&bar[XB_TOPGEN]) == tg, bar);
            __builtin_amdgcn_fence(__ATOMIC_ACQUIRE, "agent");
            xb_add(&bar[XB_XGEN(b.x)], 1u);
            asm volatile("s_waitcnt vmcnt(0)" ::: "memory");
        } else {
            XB_SPIN(xb_ld(&bar[XB_XGEN(b.x)]) == gen, bar);
            __builtin_amdgcn_fence(__ATOMIC_ACQUIRE, "agent");
            asm volatile("s_waitcnt vmcnt(0)" ::: "memory");
        }
    }
    __syncthreads();
}
struct ConvArgs { bf16* P; bf16* XBC; const float *conv_w, *conv_b, *qnw, *knw; const int* pos; };
__device__ __forceinline__ void cvt8(const v4u r, float (&f)[8]) { f[0] = bf_lo(r.x); f[1] = bf_hi(r.x); f[2] = bf_lo(r.y); f[3] = bf_hi(r.y); f[4] = bf_lo(r.z); f[5] = bf_hi(r.z); f[6] = bf_lo(r.w); f[7] = bf_hi(r.w); }
__device__ __forceinline__ void conv_phase(const Frame& F, const ConvArgs& A) {
    for (int item = F.vcu; item < BATCH * NCHUNK; item += F.G) {
        const int b = item / NCHUNK, c = item % NCHUNK;
        const size_t rowb = (size_t)b * SEQ;
        {
            const int cg8 = F.tid & 127, ch = cg8 * 8;
            float w[5][8], bias[8];
#pragma unroll
            for (int k = 0; k < 5; ++k) { const f32x4 a = *(const f32x4*)(A.conv_w + k * 1024 + ch), d = *(const f32x4*)(A.conv_w + k * 1024 + ch + 4);
                w[k][0] = a.x; w[k][1] = a.y; w[k][2] = a.z; w[k][3] = a.w; w[k][4] = d.x; w[k][5] = d.y; w[k][6] = d.z; w[k][7] = d.w; }
            { const f32x4 a = *(const f32x4*)(A.conv_b + ch), d = *(const f32x4*)(A.conv_b + ch + 4); bias[0] = a.x; bias[1] = a.y; bias[2] = a.z; bias[3] = a.w; bias[4] = d.x; bias[5] = d.y; bias[6] = d.z; bias[7] = d.w; }
#pragma unroll 1
            for (int it = 0; it < 4; ++it) {
                const int t0 = c * CH + ((F.tid >> 7) + 4 * it) * 8;
                v4u rows[12];
#pragma unroll
                for (int j = 0; j < 12; ++j) { const int t = t0 - 2 + j; rows[j] = (v4u){0u, 0u, 0u, 0u}; if (t >= 0 && t < SEQ) rows[j] = *(const v4u*)(A.P + (rowb + t) * NPROJ + PXBC + ch); }
#pragma unroll
                for (int i = 0; i < 8; ++i) {
                    float f0[8], f1[8], f2[8], f3[8], f4[8], o[8];
                    cvt8(rows[i], f0); cvt8(rows[i + 1], f1); cvt8(rows[i + 2], f2); cvt8(rows[i + 3], f3); cvt8(rows[i + 4], f4);
#pragma unroll
                    for (int j = 0; j < 8; ++j) { const float v = bias[j] + w[0][j] * f0[j] + w[1][j] * f1[j] + w[2][j] * f2[j] + w[3][j] * f3[j] + w[4][j] * f4[j]; o[j] = silu_f(v); }
                    v4u ov; ov.x = pk2(o[0], o[1]); ov.y = pk2(o[2], o[3]); ov.z = pk2(o[4], o[5]); ov.w = pk2(o[6], o[7]);
                    *(v4u*)(A.XBC + (rowb + t0 + i) * 1024 + ch) = ov;
                }
            }
        }
#pragma unroll 1
        for (int it4 = 0; it4 < 5; ++it4) {
            v4u raw[4];
#pragma unroll
            for (int u = 0; u < 4; ++u) { const int sidx = F.tid + NTHR * (4 * it4 + u), tok = sidx / 80, slot = sidx % 80; raw[u] = *(const v4u*)(A.P + (rowb + c * CH + tok) * NPROJ + PQ + slot * 8); }
#pragma unroll
            for (int u = 0; u < 4; ++u) {
                const int sidx = F.tid + NTHR * (4 * it4 + u), tok = sidx / 80, slot = sidx % 80, head = slot >> 3, part = slot & 7;
                const int t = c * CH + tok;
                bf16* p = A.P + (rowb + t) * NPROJ + PQ + slot * 8;
                float v[8]; cvt8(raw[u], v);
                float ss = 0.f;
#pragma unroll
                for (int j = 0; j < 8; ++j) ss += v[j] * v[j];
                ss += __shfl_xor(ss, 1); ss += __shfl_xor(ss, 2); ss += __shfl_xor(ss, 4);
                const float rstd = rsqrtf(ss * (1.f / 64.f) + EPS);
                const float* nw = (head < 8 ? A.qnw : A.knw) + part * 8;
                const f32x4 w0 = *(const f32x4*)nw, w1 = *(const f32x4*)(nw + 4);
                v[0] *= rstd * w0.x; v[1] *= rstd * w0.y; v[2] *= rstd * w0.z; v[3] *= rstd * w0.w; v[4] *= rstd * w1.x; v[5] *= rstd * w1.y; v[6] *= rstd * w1.z; v[7] *= rstd * w1.w;
                float oth[8];
#pragma unroll
                for (int j = 0; j < 8; ++j) oth[j] = __shfl_xor(v[j], 1);
                if (part < 2) {
                    const float posf = (float)A.pos[rowb + t];
                    const float sgn = part == 0 ? -1.f : 1.f;
                    const float inv[8] = {1.0f, 0.19392274f, 0.03760603f, 0.0072926646f, 0.0014142136f, 0.00027424819f, 5.3182957e-05f, 1.0313385e-05f};
#pragma unroll
                    for (int j = 0; j < 8; ++j) {
                        const float ang = posf * inv[j];
                        const float nrev = rintf(ang * 0.15915494309189535f);
                        float rr = fmaf(-nrev, 6.2831855f, ang); rr = fmaf(-nrev, -1.7484555e-7f, rr);
                        const float sn = __sinf(rr), cs = __cosf(rr);
                        v[j] = v[j] * cs + sgn * oth[j] * sn;
                    }
                }
                const float sc = head < 8 ? QSCALE : 1.0f;
                v4u ov; ov.x = pk2(v[0] * sc, v[1] * sc); ov.y = pk2(v[2] * sc, v[3] * sc); ov.z = pk2(v[4] * sc, v[5] * sc); ov.w = pk2(v[6] * sc, v[7] * sc);
                *(v4u*)p = ov;
            }
        }
    }
}
template <int NCOL>
__device__ __forceinline__ void stage_load(const Frame& F, v4u* tmp, const bf16* src, size_t row0, int src_pitch, int col0) {
    constexpr int CPR = NCOL / 8, PER = 128 * CPR / NTHR;
#pragma unroll
    for (int j = 0; j < PER; ++j) { const int i = F.tid + NTHR * j, r = i / CPR, cc = i % CPR; tmp[j] = *(const v4u*)(src + (row0 + r) * src_pitch + col0 + cc * 8); }
}
template <int NCOL>
__device__ __forceinline__ void stage_store(const Frame& F, const v4u* tmp, LAS unsigned char* dst, int dst_pitch) {
    constexpr int CPR = NCOL / 8, PER = 128 * CPR / NTHR;
#pragma unroll
    for (int j = 0; j < PER; ++j) { const int i = F.tid + NTHR * j, r = i / CPR, cc = i % CPR; *(LAS v4u*)(dst + r * dst_pitch + cc * 16) = tmp[j]; }
}
__device__ __forceinline__ void scan128(float& lo, float& hi, float& total, int lane) {
#pragma unroll
    for (int o = 1; o < 64; o <<= 1) { const float a = __shfl_up(lo, o), b2 = __shfl_up(hi, o); if (lane >= o) { lo += a; hi += b2; } }
    const float tl = __shfl(lo, 63); hi += tl; total = __shfl(hi, 63);
}
struct SsdArgs { const bf16* P; const bf16* XBC; const float* DT; const float *a_log, *d_skip, *ssd_nw; bf16* ST; float* CD; bf16* Y; float* ssq; };

__device__ __forceinline__ void ssd_states_phase(const Frame& F, const SsdArgs& A) {
    LAS unsigned char* Xs = F.lds + L_XS; LAS unsigned char* Bs = F.lds + L_BS; LAS float* wts = (LAS float*)(F.lds + L_ARR);
    const int lane = F.lane, h5 = lane >> 5;
    for (int item = F.vcu; item < BATCH * NCHUNK * 2; item += F.G) {
        const int g = item / (BATCH * NCHUNK), bc = item % (BATCH * NCHUNK), b = bc / NCHUNK, c = bc % NCHUNK;
        const size_t row0 = (size_t)b * SEQ + (size_t)c * CH;
        __syncthreads();
        const int hh = F.wave & 3, dir = F.wave >> 2, h = 4 * g + hh;
        const float dt0 = A.DT[(row0 + lane) * 16 + dir * 8 + h], dt1 = A.DT[(row0 + 64 + lane) * 16 + dir * 8 + h];
        {
            v4u tx[8], tb[4];
            stage_load<256>(F, tx, A.XBC, row0, 1024, g * 256); stage_load<128>(F, tb, A.XBC, row0, 1024, 512 + g * 128);
            stage_store<256>(F, tx, Xs, XS_PITCH); stage_store<128>(F, tb, Bs, BS_PITCH);
        }
        {
            const float a = -__expf(A.a_log[dir * 8 + h]);
            const float da0 = dt0 * a, da1 = dt1 * a;
            float p0 = da0, p1 = da1, tot; scan128(p0, p1, tot, lane);
            float w0, w1;
            if (dir == 0) { w0 = __expf(tot - p0) * dt0; w1 = __expf(tot - p1) * dt1; }
            else          { w0 = __expf(p0 - da0) * dt0; w1 = __expf(p1 - da1) * dt1; }
            wts[F.wave * 128 + lane] = w0; wts[F.wave * 128 + 64 + lane] = w1;
            if (lane == 0) A.CD[(bc * 2 + dir) * 8 + h] = __expf(tot);
        }
        __syncthreads();
        f32x16 acc[4][2];
#pragma unroll
        for (int nt = 0; nt < 4; ++nt)
#pragma unroll
            for (int pt = 0; pt < 2; ++pt)
#pragma unroll
                for (int r = 0; r < 16; ++r) acc[nt][pt][r] = 0.f;
#pragma unroll 2
        for (int ks = 0; ks < 8; ++ks) {
            const int s0 = 16 * ks + 8 * h5;
            const f32x4 wa = *(const LAS f32x4*)(wts + F.wave * 128 + s0), wb = *(const LAS f32x4*)(wts + F.wave * 128 + s0 + 4);
            const float wv[8] = {wa.x, wa.y, wa.z, wa.w, wb.x, wb.y, wb.z, wb.w};
            bf16x8 xb[2];
#pragma unroll
            for (int pt = 0; pt < 2; ++pt) {
                const bf16x8 raw = frag_tr(Xs, XS_PITCH, s0, s0 + 4, hh * 64 + 32 * pt, lane);
                v4u pk;
                pk.x = pk2(__uint_as_float(((unsigned)(unsigned short)raw[0]) << 16) * wv[0], __uint_as_float(((unsigned)(unsigned short)raw[1]) << 16) * wv[1]);
                pk.y = pk2(__uint_as_float(((unsigned)(unsigned short)raw[2]) << 16) * wv[2], __uint_as_float(((unsigned)(unsigned short)raw[3]) << 16) * wv[3]);
                pk.z = pk2(__uint_as_float(((unsigned)(unsigned short)raw[4]) << 16) * wv[4], __uint_as_float(((unsigned)(unsigned short)raw[5]) << 16) * wv[5]);
                pk.w = pk2(__uint_as_float(((unsigned)(unsigned short)raw[6]) << 16) * wv[6], __uint_as_float(((unsigned)(unsigned short)raw[7]) << 16) * wv[7]);
                xb[pt] = __builtin_bit_cast(bf16x8, pk);
            }
#pragma unroll
            for (int nt = 0; nt < 4; ++nt) {
                const bf16x8 bt = frag_tr_perm(Bs, BS_PITCH, s0, s0 + 4, 64 * (nt >> 1), nt & 1, lane);
#pragma unroll
                for (int pt = 0; pt < 2; ++pt) acc[nt][pt] = mfma32(bt, xb[pt], acc[nt][pt]);
            }
        }
        bf16* st = A.ST + ((size_t)((bc * 2 + dir) * 8 + h)) * 8192;
#pragma unroll
        for (int nt = 0; nt < 4; ++nt)
#pragma unroll
            for (int pt = 0; pt < 2; ++pt) { bf16* dst = st + (32 * pt + (lane & 31)) * 128 + 64 * (nt >> 1) + 32 * h5 + 16 * (nt & 1);
                v4u w0, w1; w0.x = pk2(acc[nt][pt][0], acc[nt][pt][1]); w0.y = pk2(acc[nt][pt][2], acc[nt][pt][3]); w0.z = pk2(acc[nt][pt][4], acc[nt][pt][5]); w0.w = pk2(acc[nt][pt][6], acc[nt][pt][7]);
                w1.x = pk2(acc[nt][pt][8], acc[nt][pt][9]); w1.y = pk2(acc[nt][pt][10], acc[nt][pt][11]); w1.z = pk2(acc[nt][pt][12], acc[nt][pt][13]); w1.w = pk2(acc[nt][pt][14], acc[nt][pt][15]);
                *(v4u*)dst = w0; *(v4u*)(dst + 8) = w1; }
    }
}

__device__ __forceinline__ void ssd_scan_phase(const Frame& F, const SsdArgs& A) {
    const int gt = F.vcu * NTHR + F.tid, NT = F.G * NTHR;
    for (int e = gt; e < BATCH * 2 * 8 * 64 * 32; e += NT) {
        const int n4 = e & 31, p = (e >> 5) & 63, h = (e >> 11) & 7, dir = (e >> 14) & 1, b = e >> 15;
        float st[4] = {0.f, 0.f, 0.f, 0.f};
        for (int c8 = 0; c8 < NCHUNK; c8 += 16) {
            v2u v[16]; float cd[16];
#pragma unroll
            for (int j = 0; j < 16; ++j) { const int c = dir == 0 ? (c8 + j) : (NCHUNK - 1 - c8 - j); const int bc = b * NCHUNK + c;
                v[j] = *(const v2u*)(A.ST + ((size_t)((bc * 2 + dir) * 8 + h)) * 8192 + p * 128 + 4 * n4); cd[j] = A.CD[(bc * 2 + dir) * 8 + h]; }
#pragma unroll
            for (int j = 0; j < 16; ++j) { const int c = dir == 0 ? (c8 + j) : (NCHUNK - 1 - c8 - j); const int bc = b * NCHUNK + c;
                v2u o; o.x = pk2(st[0], st[1]); o.y = pk2(st[2], st[3]);
                *(v2u*)(A.ST + ((size_t)((bc * 2 + dir) * 8 + h)) * 8192 + p * 128 + 4 * n4) = o;
                st[0] = st[0] * cd[j] + bf_lo(v[j].x); st[1] = st[1] * cd[j] + bf_hi(v[j].x); st[2] = st[2] * cd[j] + bf_lo(v[j].y); st[3] = st[3] * cd[j] + bf_hi(v[j].y); }
        }
    }
}
struct AttnArgs { const bf16* P; bf16* Y; const float* sink; const float *qnw, *knw; const float* ssq; };
__device__ __forceinline__ void attn_phase(const Frame& F, const AttnArgs& A) {
    LAS unsigned char* Ks = F.lds; LAS unsigned char* Vs = F.lds + 384 * KV_PITCH;
    const int lane = F.lane, h5 = lane >> 5, r32 = lane & 31;
    float mref;
    { float a = fabsf(A.qnw[lane]), b2 = fabsf(A.knw[lane]);
#pragma unroll
      for (int o = 1; o < 64; o <<= 1) { a = fmaxf(a, __shfl_xor(a, o)); b2 = fmaxf(b2, __shfl_xor(b2, o)); }
      mref = fminf(8.0f * LOG2E * a * b2 * 1.01f + 0.5f, 100.f); }
    v4u kt[6], vt[6];
    auto kv_fetch = [&](int item) {
        const int kvh = item / (BATCH * NCHUNK), bq = item % (BATCH * NCHUNK), b = bq / NCHUNK, qb = bq % NCHUNK; const size_t rowb = (size_t)b * SEQ;
#pragma unroll
        for (int jj = 0; jj < 6; ++jj) { const int i = F.tid + NTHR * jj, r = i >> 3, cc = i & 7, j = qb * 128 - 128 + r;
            kt[jj] = (v4u){0u, 0u, 0u, 0u}; vt[jj] = (v4u){0u, 0u, 0u, 0u};
            if (j >= 0 && j < SEQ) { const bf16* src = A.P + (rowb + j) * NPROJ + kvh * 64 + cc * 8; kt[jj] = *(const v4u*)(src + PK); vt[jj] = *(const v4u*)(src + PV); } }
    };
    if (F.vcu < BATCH * NCHUNK * 2) kv_fetch(F.vcu);
    for (int item = F.vcu; item < BATCH * NCHUNK * 2; item += F.G) {
        const int kvh = item / (BATCH * NCHUNK), bq = item % (BATCH * NCHUNK), b = bq / NCHUNK, qb = bq % NCHUNK;
        const size_t rowb = (size_t)b * SEQ;
        __syncthreads();
#pragma unroll
        for (int jj = 0; jj < 6; ++jj) { const int i = F.tid + NTHR * jj, r = i >> 3, cc = i & 7;
            *(LAS v4u*)(Ks + r * KV_PITCH + cc * 16) = kt[jj]; *(LAS v4u*)(Vs + r * KV_PITCH + cc * 16) = vt[jj]; }
        __syncthreads();
        if (item + F.G < BATCH * NCHUNK * 2) kv_fetch(item + F.G);
        const int hq = kvh * 4 + (F.wave & 3), qhalf = F.wave >> 2;
        const float sinkl = A.sink[hq] * LOG2E;
#pragma unroll 1
        for (int qt = 0; qt < 2; ++qt) {
            const int o = 64 * qhalf + 32 * qt;
            const int ir = o + r32;
            bf16x8 qf[4];
            { const bf16* qp = A.P + (rowb + qb * 128 + ir) * NPROJ + PQ + hq * 64 + 8 * h5;
#pragma unroll
              for (int kd = 0; kd < 4; ++kd) qf[kd] = *(const bf16x8*)(qp + 16 * kd); }
            float lsum = h5 == 0 ? __builtin_amdgcn_exp2f(sinkl - mref) : 0.0f;
            f32x16 oacc[2];
#pragma unroll
            for (int r = 0; r < 16; ++r) { oacc[0][r] = 0.f; oacc[1][r] = 0.f; }
#pragma unroll 1
            for (int ks = 0; ks < 6; ++ks) {
                const int kstart = -128 + 64 * ks;
                if (kstart > o + 31 + 128 || kstart + 63 < o - 128) continue;
                f32x16 st[2];
#pragma unroll
                for (int kt = 0; kt < 2; ++kt) {
#pragma unroll
                    for (int r = 0; r < 16; ++r) st[kt][r] = -mref;
#pragma unroll
                    for (int kd = 0; kd < 4; ++kd) st[kt] = mfma32(frag_row(Ks, KV_PITCH, 64 * ks + 32 * kt, 16 * kd, lane), qf[kd], st[kt]);
                }
                const bool interior = (kstart >= o + 31 - 128) && (kstart + 63 <= o + 128) && (qb * 128 + kstart >= 0) && (qb * 128 + kstart + 63 < SEQ);
                if (!interior) {
#pragma unroll
                    for (int kt = 0; kt < 2; ++kt)
#pragma unroll
                        for (int r = 0; r < 16; ++r) { const int jr = kstart + 32 * kt + crow(r, h5); const int dlt = ir - jr; const int jg = qb * 128 + jr;
                            const bool ok = dlt <= 128 && dlt >= -128 && jg >= 0 && jg < SEQ;
                            st[kt][r] = ok ? st[kt][r] : -1e30f; }
                }
                float ps = 0.f;
#pragma unroll
                for (int kt = 0; kt < 2; ++kt)
#pragma unroll
                    for (int r = 0; r < 16; ++r) { const float p = __builtin_amdgcn_exp2f(st[kt][r]); st[kt][r] = p; ps += p; }
                lsum += ps;
#pragma unroll
                for (int kt = 0; kt < 2; ++kt)
#pragma unroll
                    for (int s2 = 0; s2 < 2; ++s2) {
                        const bf16x8 pf = pack_step(st[kt], s2);
                        const int key0 = 64 * ks + 32 * kt + 16 * s2 + 4 * h5;
#pragma unroll
                        for (int dt = 0; dt < 2; ++dt) oacc[dt] = mfma32(frag_tr_perm(Vs, KV_PITCH, key0, key0 + 8, 0, dt, lane), pf, oacc[dt]);
                    }
            }
            lsum += __shfl_xor(lsum, 32);
            const float inv = sqrtf(__hip_atomic_load(A.ssq + rowb + qb * 128 + ir, __ATOMIC_RELAXED, __HIP_MEMORY_SCOPE_AGENT) * (1.f / 512.f) + EPS) / lsum;
            bf16* yp = A.Y + (rowb + qb * 128 + ir) * 1024 + 512 + hq * 64 + 32 * h5;
#pragma unroll
            for (int dt = 0; dt < 2; ++dt) {
                v4u w0, w1; w0.x = pk2(oacc[dt][0] * inv, oacc[dt][1] * inv); w0.y = pk2(oacc[dt][2] * inv, oacc[dt][3] * inv); w0.z = pk2(oacc[dt][4] * inv, oacc[dt][5] * inv); w0.w = pk2(oacc[dt][6] * inv, oacc[dt][7] * inv);
                w1.x = pk2(oacc[dt][8] * inv, oacc[dt][9] * inv); w1.y = pk2(oacc[dt][10] * inv, oacc[dt][11] * inv); w1.z = pk2(oacc[dt][12] * inv, oacc[dt][13] * inv); w1.w = pk2(oacc[dt][14] * inv, oacc[dt][15] * inv);
                *(v4u*)(yp + 16 * dt) = w0; *(v4u*)(yp + 16 * dt + 8) = w1; }
        }
    }
}
__device__ __forceinline__ void ssd_out_phase(const Frame& F, const SsdArgs& A) {
    LAS unsigned char* Xs = F.lds + L_XS; LAS unsigned char* Bs = F.lds + L_BS; LAS unsigned char* Cs = F.lds + L_CS;
    LAS float* arr = (LAS float*)(F.lds + L_ARR);
    const int lane = F.lane, h5 = lane >> 5, r32 = lane & 31;
    const int hh = F.wave & 3, lhalf = F.wave >> 2;
    for (int item = F.vcu; item < BATCH * NCHUNK * 2; item += F.G) {
        const int g = item / (BATCH * NCHUNK), bc = item % (BATCH * NCHUNK), b = bc / NCHUNK, c = bc % NCHUNK;
        const size_t row0 = (size_t)b * SEQ + (size_t)c * CH;
        const int h = 4 * g + hh;
        __syncthreads();
        {
            const int dir = F.wave >> 2;
            const float dt0 = A.DT[(row0 + lane) * 16 + dir * 8 + h], dt1 = A.DT[(row0 + 64 + lane) * 16 + dir * 8 + h];
            {
                v4u tx[8], tb[4], tc[4];
                stage_load<256>(F, tx, A.XBC, row0, 1024, g * 256); stage_load<128>(F, tb, A.XBC, row0, 1024, 512 + g * 128); stage_load<128>(F, tc, A.XBC, row0, 1024, 768 + g * 128);
                stage_store<256>(F, tx, Xs, XS_PITCH); stage_store<128>(F, tb, Bs, BS_PITCH); stage_store<128>(F, tc, Cs, BS_PITCH);
            }
            const float a = -__expf(A.a_log[dir * 8 + h]);
            const float da0 = dt0 * a, da1 = dt1 * a;
            float p0 = da0, p1 = da1, tot; scan128(p0, p1, tot, lane);
            LAS float* cs = arr + (2 * dir) * 512 + hh * 128; LAS float* dts = arr + (2 * dir + 1) * 512 + hh * 128;
            if (dir == 0) { cs[lane] = p0; cs[64 + lane] = p1; } else { cs[lane] = tot - p0 + da0; cs[64 + lane] = tot - p1 + da1; }
            dts[lane] = dt0; dts[64 + lane] = dt1;
        }
        __syncthreads();
        const float dsk = A.d_skip[h];
        const LAS float* csf = arr + hh * 128; const LAS float* dtf = arr + 512 + hh * 128; const LAS float* rsb = arr + 1024 + hh * 128; const LAS float* dtb = arr + 1536 + hh * 128;
#pragma unroll 1
        for (int lt2 = 0; lt2 < 2; ++lt2) {
            const int lt = 2 * lhalf + lt2, l = 32 * lt + r32;
            const float my_cs = csf[l], my_rs = rsb[l];
            const int ch0 = h * 64 + 32 * h5;
            v4u zz[4];
            { const bf16* zp = A.P + (row0 + l) * NPROJ + PZ + ch0;
#pragma unroll
              for (int q = 0; q < 4; ++q) zz[q] = *(const v4u*)(zp + 8 * q); }
            f32x16 yacc[2];
#pragma unroll
            for (int r = 0; r < 16; ++r) { yacc[0][r] = 0.f; yacc[1][r] = 0.f; }
            bf16x8 cf[8];
#pragma unroll
            for (int kn = 0; kn < 8; ++kn) cf[kn] = frag_row(Cs, BS_PITCH, 32 * lt, 16 * kn, lane);
#pragma unroll 1
            for (int st = 0; st < 4; ++st) {
                f32x16 cbt;
#pragma unroll
                for (int r = 0; r < 16; ++r) cbt[r] = 0.f;
#pragma unroll
                for (int kn = 0; kn < 8; ++kn) cbt = mfma32(frag_row(Bs, BS_PITCH, 32 * st, 16 * kn, lane), cf[kn], cbt);
#pragma unroll
                for (int g4 = 0; g4 < 4; ++g4) {
                    const int sb = 32 * st + 8 * g4 + 4 * h5;
                    const f32x4 c4 = *(const LAS f32x4*)(csf + sb), d4 = *(const LAS f32x4*)(dtf + sb), r4 = *(const LAS f32x4*)(rsb + sb), e4 = *(const LAS f32x4*)(dtb + sb);
#pragma unroll
                    for (int i = 0; i < 4; ++i) { const int s = sb + i; const bool fwd = s <= l;
                        const float e = fwd ? (my_cs - c4[i]) : (my_rs - r4[i]); const float dtv = fwd ? d4[i] : e4[i];
                        float mval = cbt[4 * g4 + i] * __expf(e) * dtv; if (s == l) mval += dsk; cbt[4 * g4 + i] = mval; }
                }
#pragma unroll
                for (int s2 = 0; s2 < 2; ++s2) {
                    const bf16x8 mf = pack_step(cbt, s2);
                    const int sA = 32 * st + 16 * s2 + 4 * h5;
#pragma unroll
                    for (int pt = 0; pt < 2; ++pt) yacc[pt] = mfma32(frag_tr_perm(Xs, XS_PITCH, sA, sA + 8, hh * 64, pt, lane), mf, yacc[pt]);
                }
            }
#pragma unroll 1
            for (int dir = 0; dir < 2; ++dir) {
                const bf16* stp = A.ST + ((size_t)((bc * 2 + dir) * 8 + h)) * 8192 + 8 * h5;
                bf16x8 sf[2][8];
#pragma unroll
                for (int pt = 0; pt < 2; ++pt)
#pragma unroll
                    for (int kn = 0; kn < 8; ++kn) sf[pt][kn] = *(const bf16x8*)(stp + perm_row(r32, pt) * 128 + 16 * kn);
                const float ef = __expf(dir == 0 ? my_cs : my_rs);
#pragma unroll
                for (int kn = 0; kn < 8; ++kn) {
                    const v4u cw = __builtin_bit_cast(v4u, cf[kn]);
                    v4u sw; sw.x = pk2(bf_lo(cw.x) * ef, bf_hi(cw.x) * ef); sw.y = pk2(bf_lo(cw.y) * ef, bf_hi(cw.y) * ef); sw.z = pk2(bf_lo(cw.z) * ef, bf_hi(cw.z) * ef); sw.w = pk2(bf_lo(cw.w) * ef, bf_hi(cw.w) * ef);
                    const bf16x8 cs8 = __builtin_bit_cast(bf16x8, sw);
#pragma unroll
                    for (int pt = 0; pt < 2; ++pt) yacc[pt] = mfma32(sf[pt][kn], cs8, yacc[pt]);
                }
            }
            {
                bf16* yp = A.Y + (row0 + l) * 1024 + ch0;
                float sq = 0.f;
#pragma unroll
                for (int q = 0; q < 4; ++q) {
                    const int pt = q >> 1, r0 = 8 * (q & 1);
                    const f32x4 nw0 = *(const f32x4*)(A.ssd_nw + ch0 + 8 * q), nw1 = *(const f32x4*)(A.ssd_nw + ch0 + 8 * q + 4);
                    float zf[8]; cvt8(zz[q], zf);
                    float y[8];
#pragma unroll
                    for (int i = 0; i < 8; ++i) { y[i] = yacc[pt][r0 + i] * silu_f(zf[i]); sq += y[i] * y[i]; }
                    v4u w; w.x = pk2(y[0] * nw0.x, y[1] * nw0.y); w.y = pk2(y[2] * nw0.z, y[3] * nw0.w); w.z = pk2(y[4] * nw1.x, y[5] * nw1.y); w.w = pk2(y[6] * nw1.z, y[7] * nw1.w);
                    *(v4u*)(yp + 8 * q) = w;
                }
                sq += __shfl_xor(sq, 32);
                if (h5 == 0) __hip_atomic_fetch_add(A.ssq + row0 + l, sq, __ATOMIC_RELAXED, __HIP_MEMORY_SCOPE_AGENT);
            }
        }
    }
}
#ifndef MK_ONE_LAUNCH
#define MK_ONE_LAUNCH 1
#endif
constexpr int NPHASE = 12;
struct Args { const float* in[25]; float* out; unsigned char* ws; int ph_lo, ph_hi; };
__global__ void __launch_bounds__(NTHR, 2) hybrid_fwd(Args args) {
    extern __shared__ __attribute__((aligned(16))) unsigned char lds_raw[];
    Frame F;
    F.lds = (LAS unsigned char*)lds_raw;
    F.tid = threadIdx.x; F.lane = F.tid & 63; F.wave = __builtin_amdgcn_readfirstlane(F.tid >> 6);
    F.G = gridDim.x; { const int bx = blockIdx.x; F.vcu = (F.G % 8 == 0) ? (bx % 8) * (F.G / 8) + bx / 8 : bx; }
    unsigned char* ws = args.ws;
    const float* x = args.in[0]; const float* cvec = args.in[1]; const int* pos = (const int*)args.in[2];
    const float *w_ada = args.in[3], *b_ada = args.in[4], *norm_ffn1 = args.in[5], *ffn1_wg = args.in[6], *ffn1_wu = args.in[7], *ffn1_wd = args.in[8], *norm_mix = args.in[9], *w_in = args.in[10];
    const float *conv_w = args.in[11], *conv_b = args.in[12], *dt_bias = args.in[13], *a_log = args.in[14], *d_skip = args.in[15], *ssd_nw = args.in[16], *qnw = args.in[17], *knw = args.in[18], *sink = args.in[19];
    const float *w_out = args.in[20], *norm_ffn2 = args.in[21], *ffn2_wg = args.in[22], *ffn2_wu = args.in[23], *ffn2_wd = args.in[24];
    float* out = args.out;
    float* mod = (float*)(ws + WS_CTL + CTL_MOD);
    bf16 *WGU1 = (bf16*)(ws + WS_WGU1), *WD1 = (bf16*)(ws + WS_WD1), *WINB = (bf16*)(ws + WS_WINB), *WOUT = (bf16*)(ws + WS_WOUT), *WGU2B = (bf16*)(ws + WS_WGU2B), *WD2 = (bf16*)(ws + WS_WD2);
    float* DT = (float*)(ws + WS_DT); float* CD = (float*)(ws + WS_CD); float* ssq = (float*)(ws + WS_CTL + CTL_SSQ); float* rssq1 = (float*)(ws + WS_CTL + CTL_RSSQ1); float* rssq2 = (float*)(ws + WS_CTL + CTL_RSSQ2); float* sW2 = (float*)(ws + WS_CTL + CTL_SW2); float* rowsc = (float*)(ws + WS_CTL + CTL_ROWSC); unsigned* cmax = (unsigned*)(ws + WS_CTL + CTL_CMAX); float* colsc = (float*)(ws + WS_CTL + CTL_COLSC);
    signed char* WGU1Q = (signed char*)(ws + WS_WGU1); signed char* WGU2Q = (signed char*)(ws + WS_WGU2); signed char* UQ = (signed char*)(ws + WS_U);
    bf16 *U = (bf16*)(ws + WS_U), *H = (bf16*)(ws + WS_H), *P = (bf16*)(ws + WS_H), *XBC = (bf16*)out, *ST = (bf16*)out + (size_t)M * 1024, *X1 = (bf16*)(ws + WS_X1);
    const int lo = args.ph_lo, hi = args.ph_hi;
    cg::grid_group grid = cg::this_grid();
    volatile LAS unsigned* xbst = (volatile LAS unsigned*)(F.lds + L_END);
    if (F.tid < 2) xbst[F.tid] = 0u;
    __syncthreads();
    XcdBarrier bar; bar.bar = (unsigned*)(ws + WS_CTL + CTL_BAR); bar.x = 0; bar.st = xbst;
    if (hi - lo > 1) bar = xcd_barrier_post((unsigned*)(ws + WS_CTL + CTL_BAR), xbst);
#ifndef PHM
#define PHM 0xffff
#endif
#ifndef WGM_N4
#define WGM_N4 2
#endif
#ifndef EPI_ALIGN
#define EPI_ALIGN true
#endif
#ifndef DUPM
#define DUPM 0
#endif
#define IN(k) (((PHM >> (k)) & 1) && lo <= (k) && (k) < hi)
#define SEAM(k) do { if (IN(k) && IN((k) + 1)) xcd_barrier(bar); } while (0)
#define DUP(k) (((DUPM >> (k)) & 1) != 0)
#define PHASE(k, ...) if (IN(k)) { __VA_ARGS__; if (DUP(k)) { xcd_barrier(bar); __VA_ARGS__; } } SEAM(k);
    if (lo > hi) grid.sync();
    PHASE(0, { P0Args A{ffn1_wg, ffn1_wu, ffn1_wd, w_out, ffn2_wd, cvec, w_ada, b_ada, ffn2_wg, ffn2_wu, WGU1, WD1, WOUT, WD2, mod, cmax}; p0_prologue(F, A); })
    PHASE(1, { norm_q_phase<false>(F, x, norm_ffn1, mod, 0, 1, UQ, rowsc); PrepArgs A{w_in, ffn1_wg, ffn1_wu, ffn2_wg, ffn2_wu, norm_mix, mod, WINB, sW2, WGU1Q, WGU2Q, cmax, colsc}; prep_phase(F, A); })
    PHASE(2, { pg8::Gemm g{(const bf16*)UQ, (const bf16*)WGU1Q, M, NGU, D / 2, 0, 1 << 30}; pg8::StaticOrder S; S.init(M, NGU, F.G, (int)blockIdx.x); pg8::EpiSwiGLUq E{H, rowsc, colsc, DFF};
        pg8::gemm_phase<pg8::EpiSwiGLUq, pg8::StaticOrder, true, true, true>(F.lds, g, S, E); })
    PHASE(3, { pg8::Gemm g{H, WD1, M, D, DFF, 0, 1 << 30}; pg8::StaticOrder S; S.init(M, D, F.G, (int)blockIdx.x, WGM_N4); pg8::EpiResid<false, true, false, true> E{x, X1, mod + 2 * D, nullptr, rssq1, D, NMOD, SEQ, 0.5f, 0.f};
        pg8::gemm_phase<pg8::EpiResid<false, true, false, true>, pg8::StaticOrder, EPI_ALIGN, true>(F.lds, g, S, E); })
    PHASE(4, { pg8::Gemm g{X1, WINB, M, NPROJ_PAD, D, (size_t)NPROJ_PAD * D * 2, SEQ / 256}; pg8::StaticOrder S; S.init(M, NPROJ_PAD, F.G, (int)blockIdx.x); pg8::EpiProj E{P, DT, dt_bias, rssq1, sW2, NPROJ, NPROJ / 256, NPROJ_PAD, SEQ};
        pg8::gemm_phase<pg8::EpiProj, pg8::StaticOrder, true, true>(F.lds, g, S, E); })
    PHASE(5, { ConvArgs A{P, XBC, conv_w, conv_b, qnw, knw, pos}; conv_phase(F, A); if (F.G != BATCH * NCHUNK) xcd_barrier(bar); else __syncthreads();
               SsdArgs B{P, XBC, DT, a_log, d_skip, ssd_nw, ST, CD, U, ssq}; ssd_states_phase(F, B); })
    PHASE(6, { SsdArgs A{P, XBC, DT, a_log, d_skip, ssd_nw, ST, CD, U, ssq}; ssd_scan_phase(F, A); })
    PHASE(7, { SsdArgs A{P, XBC, DT, a_log, d_skip, ssd_nw, ST, CD, U, ssq}; ssd_out_phase(F, A); if (F.G != BATCH * NCHUNK) xcd_barrier(bar); else __syncthreads();
               AttnArgs B{P, U, sink, qnw, knw, ssq}; attn_phase(F, B); })
    PHASE(8, { pg8::Gemm g{U, WOUT, M, D, D, 0, 1 << 30}; pg8::StaticOrder S; S.init(M, D, F.G, (int)blockIdx.x, WGM_N4); pg8::EpiResid<true, true, true, false> E{X1, X1, mod + 5 * D, ssq, nullptr, D, NMOD, SEQ, 1.0f, 1.f / 512.f};
        pg8::gemm_phase<pg8::EpiResid<true, true, true, false>, pg8::StaticOrder, EPI_ALIGN, true>(F.lds, g, S, E); })
    PHASE(9, { norm_q_phase<true>(F, X1, norm_ffn2, mod, 6, 7, UQ, rowsc); })
    PHASE(10, { pg8::Gemm g{(const bf16*)UQ, (const bf16*)WGU2Q, M, NGU, D / 2, 0, 1 << 30}; pg8::StaticOrder S; S.init(M, NGU, F.G, (int)blockIdx.x); pg8::EpiSwiGLUq E{H, rowsc, colsc + NGU, DFF};
        pg8::gemm_phase<pg8::EpiSwiGLUq, pg8::StaticOrder, true, true, true>(F.lds, g, S, E); })
    PHASE(11, { pg8::Gemm g{H, WD2, M, D, DFF, 0, 1 << 30}; pg8::StaticOrder S; S.init(M, D, F.G, (int)blockIdx.x, WGM_N4); pg8::EpiResid<true, false> E{X1, out, mod + 8 * D, nullptr, nullptr, D, NMOD, SEQ, 0.5f, 0.f};
        pg8::gemm_phase<pg8::EpiResid<true, false>, pg8::StaticOrder, EPI_ALIGN, true>(F.lds, g, S, E); })
#undef IN
#undef SEAM
}

extern "C" void kernel_launch(void* const* d_in, const int* in_sizes, int n_in, void* d_out, int out_size, void* d_ws, size_t ws_size, hipStream_t stream) {
    static int grid = 0;
    if (grid == 0) {
        if (n_in != 25 || in_sizes[0] != M * D || out_size != M * D || ws_size < WS_END) { fprintf(stderr, "kernel_launch: unexpected shapes (n_in %d, in0 %d, out %d, ws %zu)\n", n_in, n_in > 0 ? in_sizes[0] : -1, out_size, ws_size); grid = -1; return; }
        int dev = 0, cus = 0, per_cu = 0;
        if (hipGetDevice(&dev) != hipSuccess || hipDeviceGetAttribute(&cus, hipDeviceAttributeMultiprocessorCount, dev) != hipSuccess) { grid = -1; return; }
        if (hipFuncSetAttribute((const void*)hybrid_fwd, hipFuncAttributeMaxDynamicSharedMemorySize, LDS_BYTES) != hipSuccess) { fprintf(stderr, "kernel_launch: hipFuncSetAttribute failed\n"); grid = -1; return; }
        if (hipOccupancyMaxActiveBlocksPerMultiprocessor(&per_cu, (const void*)hybrid_fwd, NTHR, LDS_BYTES) != hipSuccess || per_cu < 1) { fprintf(stderr, "kernel_launch: occupancy query says %d\n", per_cu); per_cu = 1; }
        (void)hipGetLastError();
        grid = cus * per_cu;
        if (grid > 256) grid = 256;
    }
    if (grid < 0) return;
    if (hipMemsetAsync((char*)d_ws + WS_CTL, 0, CTL_ZERO_BYTES, stream) != hipSuccess) { fprintf(stderr, "kernel_launch: memset failed\n"); return; }
    Args a{};
    for (int i = 0; i < 25; ++i) a.in[i] = (const float*)d_in[i];
    a.out = (float*)d_out; a.ws = (unsigned char*)d_ws;
#if MK_ONE_LAUNCH
    a.ph_lo = 0; a.ph_hi = NPHASE;
    void* kargs[] = {&a};
    hipError_t e = hipLaunchCooperativeKernel((const void*)hybrid_fwd, dim3(grid), dim3(NTHR), kargs, LDS_BYTES, stream);
    if (e != hipSuccess) fprintf(stderr, "kernel_launch: cooperative launch failed: %s (grid %d)\n", hipGetErrorString(e), grid);
#else
    for (int p = 0; p < NPHASE; ++p) { a.ph_lo = p; a.ph_hi = p + 1; hipLaunchKernelGGL(hybrid_fwd, dim3(grid), dim3(NTHR), LDS_BYTES, stream, a); }
#endif
}
```
